# Optimizing an MI355X kernel written in HIP

```python
import math
import jax, jax.numpy as jnp
from jax import lax
import numpy as np

D_MODEL = 1024
BATCH = 16
SEQ = 2048
DEPTH = 1

GRID_W = 64
ROPE_THETA = 10000.0
Q_BLOCK = 128
EPS = 1e-6

MLA_HEADS = 8
Q_LORA = 384
KV_LORA = 256
MLA_NOPE = 64
MLA_ROPE = 32
MLA_V = 64
MLA_QK = MLA_NOPE + MLA_ROPE

GQA_HEADS = 8
GQA_KV_HEADS = 2
GQA_HD = 64

IN_SPLITS = (Q_LORA, KV_LORA, MLA_ROPE, GQA_HEADS * GQA_HD, GQA_KV_HEADS * GQA_HD, GQA_KV_HEADS * GQA_HD)
IN_WIDTH = sum(IN_SPLITS)
MLA_OUT = MLA_HEADS * MLA_V
GQA_OUT = GQA_HEADS * GQA_HD
MIX_WIDTH = MLA_OUT + GQA_OUT

D_FF = int(math.ceil((8 * D_MODEL / 3) / 256) * 256)

kernel_name = "hybrid_mla_gqa_axial_encoder_block"


def rmsnorm(x, g):
    xf = x.astype(jnp.float32)
    y = xf * lax.rsqrt(jnp.mean(xf * xf, axis=-1, keepdims=True) + EPS)
    return (y * g.astype(jnp.float32)).astype(x.dtype)


def axial_angles(rows, d_rot):
    d_ax = d_rot // 2
    inv = ROPE_THETA ** (-(jnp.arange(0, d_ax, 2, dtype=jnp.float32) / d_ax))
    row = jnp.repeat(jnp.arange(rows, dtype=jnp.float32), GRID_W)
    col = jnp.tile(jnp.arange(GRID_W, dtype=jnp.float32), rows)
    return row[:, None] * inv[None, :], col[:, None] * inv[None, :]


def rotate(x, ang):
    n = x.shape[-1] // 2
    c = jnp.cos(ang)[:, None, :].astype(x.dtype)
    s = jnp.sin(ang)[:, None, :].astype(x.dtype)
    x1, x2 = x[..., :n], x[..., n:]
    return jnp.concatenate([x1 * c - x2 * s, x1 * s + x2 * c], axis=-1)


def axial_rope(x, ang_r, ang_c):
    d_ax = x.shape[-1] // 2
    return jnp.concatenate([rotate(x[..., :d_ax], ang_r), rotate(x[..., d_ax:], ang_c)], axis=-1)


def blocked_attention(q, k, v, scale):
    B, S, H, D = q.shape
    Hk = k.shape[2]
    G = H // Hk
    Dv = v.shape[-1]
    nb = S // Q_BLOCK
    kf = k.astype(jnp.float32)
    vf = v.astype(jnp.float32)
    qb = q.reshape(B, nb, Q_BLOCK, Hk, G, D).transpose(1, 0, 3, 4, 2, 5)

    def one_block(qblk):
        s = jnp.einsum('bkgqd,bskd->bkgqs', qblk.astype(jnp.float32), kf) * scale
        p = jax.nn.softmax(s, axis=-1)
        return jnp.einsum('bkgqs,bskd->bkgqd', p, vf)

    o = lax.map(one_block, qb)
    o = o.transpose(1, 0, 4, 2, 3, 5).reshape(B, S, H * Dv)
    return o.astype(q.dtype)


def setup_inputs(seed: int = 0) -> dict:
    key = jax.random.key(seed)
    ks = jax.random.split(key, 20)
    L = DEPTH

    def w(k, shape, fan_in):
        return jax.random.normal(k, shape, jnp.float32) * (fan_in ** -0.5)

    def gain(k, n):
        return 1.0 + 0.02 * jax.random.normal(k, (L, n), jnp.float32)

    return {
        "x": jax.random.normal(ks[0], (BATCH, SEQ, D_MODEL), jnp.float32),
        "norm1_g": gain(ks[1], D_MODEL),
        "w_in": w(ks[2], (L, D_MODEL, IN_WIDTH), D_MODEL),
        "q_a_norm_g": gain(ks[3], Q_LORA),
        "w_q_b": w(ks[4], (L, Q_LORA, MLA_HEADS * MLA_QK), Q_LORA),
        "kv_a_norm_g": gain(ks[5], KV_LORA),
        "w_kv_b": w(ks[6], (L, KV_LORA, MLA_HEADS * (MLA_NOPE + MLA_V)), KV_LORA),
        "mla_q_norm_g": gain(ks[7], MLA_QK),
        "mla_k_norm_g": gain(ks[8], MLA_QK),
        "gqa_q_norm_g": gain(ks[9], GQA_HD),
        "gqa_k_norm_g": gain(ks[10], GQA_HD),
        "mla_out_norm_g": gain(ks[11], MLA_OUT),
        "gqa_out_norm_g": gain(ks[12], GQA_OUT),
        "w_o": w(ks[13], (L, MIX_WIDTH, D_MODEL), MIX_WIDTH),
        "norm2_g": gain(ks[14], D_MODEL),
        "w_gate": w(ks[15], (L, D_MODEL, D_FF), D_MODEL),
        "w_up": w(ks[16], (L, D_MODEL, D_FF), D_MODEL),
        "w_down": w(ks[17], (L, D_FF, D_MODEL), D_FF),
    }


def reference(x, norm1_g, w_in, q_a_norm_g, w_q_b, kv_a_norm_g, w_kv_b,
              mla_q_norm_g, mla_k_norm_g, gqa_q_norm_g, gqa_k_norm_g,
              mla_out_norm_g, gqa_out_norm_g, w_o, norm2_g, w_gate, w_up, w_down):
    B, S, _ = x.shape
    rows = S // GRID_W
    ang_r_mla, ang_c_mla = axial_angles(rows, MLA_ROPE)
    ang_r_gqa, ang_c_gqa = axial_angles(rows, GQA_HD)
    offsets = list(np.cumsum(IN_SPLITS)[:-1])

    for l in range(DEPTH):
        h = rmsnorm(x, norm1_g[l])
        p = h @ w_in[l]
        cq, ckv, kpe, gq, gk, gv = jnp.split(p, offsets, axis=-1)

        cq = rmsnorm(cq, q_a_norm_g[l])
        q_a = (cq @ w_q_b[l]).reshape(B, S, MLA_HEADS, MLA_QK)
        ckv = rmsnorm(ckv, kv_a_norm_g[l])
        kv = (ckv @ w_kv_b[l]).reshape(B, S, MLA_HEADS, MLA_NOPE + MLA_V)
        k_nope, v_a = kv[..., :MLA_NOPE], kv[..., MLA_NOPE:]
        k_pe = jnp.broadcast_to(kpe[:, :, None, :], (B, S, MLA_HEADS, MLA_ROPE))
        k_a = jnp.concatenate([k_nope, k_pe], axis=-1)
        q_a = rmsnorm(q_a, mla_q_norm_g[l])
        k_a = rmsnorm(k_a, mla_k_norm_g[l])
        q_a = jnp.concatenate([q_a[..., :MLA_NOPE], axial_rope(q_a[..., MLA_NOPE:], ang_r_mla, ang_c_mla)], axis=-1)
        k_a = jnp.concatenate([k_a[..., :MLA_NOPE], axial_rope(k_a[..., MLA_NOPE:], ang_r_mla, ang_c_mla)], axis=-1)
        o_a = blocked_attention(q_a, k_a, v_a, MLA_QK ** -0.5)

        q_b = rmsnorm(gq.reshape(B, S, GQA_HEADS, GQA_HD), gqa_q_norm_g[l])
        k_b = rmsnorm(gk.reshape(B, S, GQA_KV_HEADS, GQA_HD), gqa_k_norm_g[l])
        v_b = gv.reshape(B, S, GQA_KV_HEADS, GQA_HD)
        q_b = axial_rope(q_b, ang_r_gqa, ang_c_gqa)
        k_b = axial_rope(k_b, ang_r_gqa, ang_c_gqa)
        o_b = blocked_attention(q_b, k_b, v_b, GQA_HD ** -0.5)

        mixed = jnp.concatenate([rmsnorm(o_a, mla_out_norm_g[l]), rmsnorm(o_b, gqa_out_norm_g[l])], axis=-1)
        x = x + mixed @ w_o[l]

        h2 = rmsnorm(x, norm2_g[l])
        x = x + (jax.nn.silu(h2 @ w_gate[l]) * (h2 @ w_up[l])) @ w_down[l]
    return x
```

```cpp
#include <hip/hip_runtime.h>
#include <hip/hip_cooperative_groups.h>
#include <cstdio>
#include <cstdint>
namespace cg = cooperative_groups;
constexpr size_t WSC_MiB = 1u << 20;
constexpr size_t WSC_SSQ_X1 = 64 * 1024, WSC_SSQ_CQ = 192 * 1024, WSC_SSQ_CKV = 320 * 1024, WSC_SSQ_OA = 448 * 1024, WSC_SSQ_OB = 576 * 1024;
constexpr size_t WSC_P = 96 * WSC_MiB, WSC_QAR = 192 * WSC_MiB, WSC_KNR = 240 * WSC_MiB, WSC_H = 96 * WSC_MiB, WSC_VTA = 272 * WSC_MiB, WSC_VTB = 304 * WSC_MiB, WSC_X1B = 320 * WSC_MiB;
namespace pg8 {
#define PG8_LAS __attribute__((address_space(3)))
typedef unsigned short bf16_t;
typedef short bf16x8 __attribute__((ext_vector_type(8)));
typedef float f32x4 __attribute__((ext_vector_type(4)));
typedef unsigned u32x4 __attribute__((ext_vector_type(4)));
constexpr int BM = 256, BK = 64, HALF = 128, HTB = HALF * BK * 2  , STAGE_BYTES = 8 * HTB, NXCD = 8, WGM = 8;

__host__ __device__ __forceinline__ int lds_byte(int r, int c) { const int st = (r >> 4) * 2 + (c >> 5), rr = r & 15, cc = c & 31, ob = rr * 64 + cc * 2; return st * 1024 + (ob ^ (((ob >> 9) & 1) << 5)); }
__host__ __device__ __forceinline__ void stage_rc(int b, int& R, int& C) { const int st = b / 1024, sb = b % 1024, swz = sb ^ (((sb >> 9) & 1) << 5); R = (st >> 1) * 16 + swz / 64; C = (st & 1) * 32 + (swz % 64) / 2; }
__host__ __device__ __forceinline__ int perm32(int rho) { const int n = rho >> 4, i = rho & 15; return 8 * (i >> 2) + 4 * n + (i & 3); }

struct Unit { int pm, pn; };
struct Gemm { const bf16_t* A; const bf16_t* Bt; int M, N, K, lda, ldb; size_t kstepA, kstepB; };

struct StaticOrder {
    int nM, nN, nwg, G, c;
    __host__ __device__ void init(int M, int N, int G_, int c_) { nM = M / BM; nN = N / BM; nwg = nM * nN; G = G_; c = c_; }
    __host__ __device__ bool next(int i, Unit& u) const {
        const long L = (long)i * G + c; if (L >= nwg) return false;
        int wgid = (int)L; const int xcd_ = wgid % NXCD; { const int q = nwg / NXCD, r = nwg % NXCD, xcd = wgid % NXCD, off = wgid / NXCD; wgid = (xcd < r ? xcd * (q + 1) : r * (q + 1) + (xcd - r) * q) + off; }
        const int nig = WGM * nN, gid = wgid / nig, fm = gid * WGM, gsz = (nM - fm) < WGM ? (nM - fm) : WGM;
        u.pm = fm + ((wgid % nig) % gsz); u.pn = ((wgid % nig) / gsz + (xcd_ * nN) / NXCD) % nN; return true;
    }
    __device__ __forceinline__ void a_ready(const Unit&) const {}
    __device__ __forceinline__ void done(const Unit&) const {}
};


typedef float f32x2 __attribute__((ext_vector_type(2)));
typedef unsigned u32x2 __attribute__((ext_vector_type(2)));
typedef __bf16 bf16x2v __attribute__((ext_vector_type(2)));
__device__ __forceinline__ unsigned cvt_pk_bf16(float lo, float hi) { f32x2 v = {lo, hi}; bf16x2v b = __builtin_convertvector(v, bf16x2v); return __builtin_bit_cast(unsigned, b); }
__device__ __forceinline__ bf16_t cvt_bf16(float x) { return (bf16_t)(cvt_pk_bf16(x, 0.f) & 0xffffu); }

struct EpiBf16 {
    static constexpr bool PERM = true, AFTER_DRAIN = false, HAS_MID = false;
    bf16_t* O; int ldc; int mode; bf16_t* VT; int ldt; const float* ssq_in; float inv_n; float* ssq_a; float* ssq_b;
    const bf16_t* Pk; bf16_t* Kout; const float* gk;
    __device__ __forceinline__ void vt_store(const f32x4 (&acc)[2][2][4][2], const float (&rs)[2][4], int row0, int vrow0, int fq) const {
        asm volatile("" : "+v"(row0), "+v"(fq));
#pragma unroll
        for (int bj = 0; bj < 2; ++bj)
#pragma unroll
            for (int ai = 0; ai < 2; ++ai)
#pragma unroll
                for (int m = 0; m < 4; ++m) {
                    const f32x4 v0 = acc[ai][bj][m][0] * rs[ai][m], v1 = acc[ai][bj][m][1] * rs[ai][m];
                    bf16_t* p = VT + (size_t)(vrow0 + bj * 32 + 8 * fq) * ldt + (row0 + ai * HALF + m * 16);
#pragma unroll
                    for (int i = 0; i < 4; ++i) { p[(size_t)i * ldt] = cvt_bf16(v0[i]); p[(size_t)(i + 4) * ldt] = cvt_bf16(v1[i]); }
                }
    }
    __device__ __forceinline__ void operator()(const f32x4 (&acc)[2][2][4][2], const Unit& u, int wr, int wc, int fr, int fq) const {
        const int row0 = u.pm * BM + wr * 64 + fr, col0 = u.pn * BM + wc * 32 + 8 * fq;
        float rs[2][4];
#pragma unroll
        for (int ai = 0; ai < 2; ++ai)
#pragma unroll
            for (int m = 0; m < 4; ++m) rs[ai][m] = ssq_in ? (__builtin_amdgcn_rsqf(ssq_in[row0 + ai * HALF + m * 16] * inv_n + 1e-6f)) : 1.0f;
        if (mode == 1 && u.pn == 5) {
            if (wc >= 2) { vt_store(acc, rs, row0, (wc - 2) * 64, fq); return; }
            int fql = fq; asm volatile("" : "+v"(fql));
            float g[2][8], inv[8];
            { const float* gp = gk + 8 * fql;
#pragma unroll
              for (int e = 0; e < 8; ++e) { g[0][e] = gp[e]; g[1][e] = gp[32 + e]; inv[e] = __builtin_amdgcn_exp2f(-(float)(8 * (fql & 1) + e) * (13.287712379549449f / 16.0f)); } }
#pragma unroll
            for (int ai = 0; ai < 2; ++ai)
#pragma unroll
                for (int m = 0; m < 4; ++m) {
                    const int row = row0 + ai * HALF + m * 16, b = row >> 11, s = row & 2047;
                    float v[2][8]; float ss = 0.f;
#pragma unroll
                    for (int bj = 0; bj < 2; ++bj)
#pragma unroll
                        for (int e = 0; e < 8; ++e) { v[bj][e] = acc[ai][bj][m][e >> 2][e & 3]; ss += v[bj][e] * v[bj][e]; }
                    ss += __shfl_xor(ss, 16); ss += __shfl_xor(ss, 32);
                    const float rk = __builtin_amdgcn_rsqf(ss * (1.f / 64.f) + 1e-6f);
                    bf16_t* dst = Kout + ((size_t)(b * 2 + wc) * 2048 + s) * 64 + 8 * fql;
#pragma unroll
                    for (int bj = 0; bj < 2; ++bj) {
                        const float pos = bj ? (float)(s & 63) : (float)(s >> 6);
                        float o[8];
#pragma unroll
                        for (int e = 0; e < 8; ++e) { const float y = v[bj][e] * rk * g[bj][e], py = __shfl_xor(y, 32); const float ang = pos * inv[e], c = __cosf(ang), sn = __sinf(ang);
                            o[e] = (fq & 2) ? (py * sn + y * c) : (y * c - py * sn); }
                        u32x4 w; w.x = cvt_pk_bf16(o[0], o[1]); w.y = cvt_pk_bf16(o[2], o[3]); w.z = cvt_pk_bf16(o[4], o[5]); w.w = cvt_pk_bf16(o[6], o[7]);
                        *(u32x4*)(dst + bj * 32) = w;
                    }
                }
            return;
        }
        if (mode == 2) {
            const int head = 2 * u.pn + (wc >> 1);
            if (wc & 1) { vt_store(acc, rs, row0, head * 64, fq); return; }
            int fql = fq; asm volatile("" : "+v"(fql));
            float g[2][8], gr[8], inv[8];
            { const float* gp = gk + 8 * fql;
#pragma unroll
              for (int e = 0; e < 8; ++e) { g[0][e] = gp[e]; g[1][e] = gp[32 + e]; gr[e] = gp[64 + e]; inv[e] = __builtin_amdgcn_exp2f(-(float)e * (13.287712379549449f / 8.0f)); } }
#pragma unroll
            for (int ai = 0; ai < 2; ++ai)
#pragma unroll
                for (int m = 0; m < 4; ++m) {
                    const int row = row0 + ai * HALF + m * 16, b = row >> 11, s = row & 2047;
                    const u32x4 kw = *(const u32x4*)(Pk + (size_t)row * 1536 + 640 + 8 * fql);
                    float kp[8] = {__uint_as_float(kw.x << 16), __uint_as_float(kw.x & 0xffff0000u), __uint_as_float(kw.y << 16), __uint_as_float(kw.y & 0xffff0000u),
                                   __uint_as_float(kw.z << 16), __uint_as_float(kw.z & 0xffff0000u), __uint_as_float(kw.w << 16), __uint_as_float(kw.w & 0xffff0000u)};
                    float v[2][8]; float ss = 0.f;
#pragma unroll
                    for (int bj = 0; bj < 2; ++bj)
#pragma unroll
                        for (int e = 0; e < 8; ++e) { v[bj][e] = acc[ai][bj][m][e >> 2][e & 3] * rs[ai][m]; ss += v[bj][e] * v[bj][e]; }
#pragma unroll
                    for (int e = 0; e < 8; ++e) ss += kp[e] * kp[e];
                    ss += __shfl_xor(ss, 16); ss += __shfl_xor(ss, 32);
                    const float rk = __builtin_amdgcn_rsqf(ss * (1.f / 96.f) + 1e-6f);
                    bf16_t* dst = Kout + ((size_t)(b * 8 + head) * 2048 + s) * 96 + 8 * fql;
#pragma unroll
                    for (int bj = 0; bj < 2; ++bj) {
                        u32x4 w; w.x = cvt_pk_bf16(v[bj][0] * rk * g[bj][0], v[bj][1] * rk * g[bj][1]); w.y = cvt_pk_bf16(v[bj][2] * rk * g[bj][2], v[bj][3] * rk * g[bj][3]);
                        w.z = cvt_pk_bf16(v[bj][4] * rk * g[bj][4], v[bj][5] * rk * g[bj][5]); w.w = cvt_pk_bf16(v[bj][6] * rk * g[bj][6], v[bj][7] * rk * g[bj][7]);
                        *(u32x4*)(dst + bj * 32) = w;
                    }
                    const float pos = (fq & 2) ? (float)(s & 63) : (float)(s >> 6);
                    float o[8];
#pragma unroll
                    for (int e = 0; e < 8; ++e) { const float y = kp[e] * rk * gr[e], py = __shfl_xor(y, 16); const float ang = pos * inv[e], c = __cosf(ang), sn = __sinf(ang);
                        o[e] = (fq & 1) ? (py * sn + y * c) : (y * c - py * sn); }
                    u32x4 w; w.x = cvt_pk_bf16(o[0], o[1]); w.y = cvt_pk_bf16(o[2], o[3]); w.z = cvt_pk_bf16(o[4], o[5]); w.w = cvt_pk_bf16(o[6], o[7]);
                    *(u32x4*)(dst + 64) = w;
                }
            return;
        }
#pragma unroll
        for (int bj = 0; bj < 2; ++bj) {
            const int c8 = col0 + bj * HALF;
            if (mode == 1) {
                const int cb = u.pn * BM + bj * HALF + wc * 32;
                float* sq = (cb < 384) ? ssq_a : ((cb < 640) ? ssq_b : nullptr);
                if (sq) {
#pragma unroll
                    for (int ai = 0; ai < 2; ++ai)
#pragma unroll
                        for (int m = 0; m < 4; ++m) {
                            const f32x4 v0 = acc[ai][bj][m][0], v1 = acc[ai][bj][m][1];
                            float s = (v0[0] * v0[0] + v0[1] * v0[1]) + (v0[2] * v0[2] + v0[3] * v0[3]) + (v1[0] * v1[0] + v1[1] * v1[1]) + (v1[2] * v1[2] + v1[3] * v1[3]);
                            s += __shfl_xor(s, 16); s += __shfl_xor(s, 32);
                            if (fq == 0) unsafeAtomicAdd(sq + row0 + ai * HALF + m * 16, s);
                        }
                }
            }
#pragma unroll
            for (int ai = 0; ai < 2; ++ai)
#pragma unroll
                for (int m = 0; m < 4; ++m) {
                    const f32x4 v0 = acc[ai][bj][m][0] * rs[ai][m], v1 = acc[ai][bj][m][1] * rs[ai][m];
                    u32x4 w; w.x = cvt_pk_bf16(v0[0], v0[1]); w.y = cvt_pk_bf16(v0[2], v0[3]); w.z = cvt_pk_bf16(v1[0], v1[1]); w.w = cvt_pk_bf16(v1[2], v1[3]);
                    *(u32x4*)(O + (size_t)(row0 + ai * HALF + m * 16) * ldc + c8) = w;
                }
        }
    }
};
struct EpiRes {
    static constexpr bool PERM = false, AFTER_DRAIN = false, HAS_MID = false;
    const float* resid; float* out; int ldc;
    __device__ __forceinline__ void operator()(const f32x4 (&acc)[2][2][4][2], const Unit& u, int wr, int wc, int fr, int fq) const {
        const int row0 = u.pm * BM + wr * 64 + fr, col0 = u.pn * BM + wc * 32 + 4 * fq;
#pragma unroll
        for (int ai = 0; ai < 2; ++ai)
#pragma unroll
            for (int m = 0; m < 4; ++m) {
                const size_t off = (size_t)(row0 + ai * HALF + m * 16) * ldc + col0;
#pragma unroll
                for (int bj = 0; bj < 2; ++bj)
#pragma unroll
                    for (int n = 0; n < 2; ++n) { const f32x4 r = *(const f32x4*)(resid + off + bj * HALF + n * 16); *(f32x4*)(out + off + bj * HALF + n * 16) = r + acc[ai][bj][m][n]; }
            }
    }
};
struct EpiResB {
    static constexpr bool PERM = false, AFTER_DRAIN = false, HAS_MID = false;
    const bf16_t* residb; float* out; int ldc;
    __device__ __forceinline__ void operator()(const f32x4 (&acc)[2][2][4][2], const Unit& u, int wr, int wc, int fr, int fq) const {
        const int row0 = u.pm * BM + wr * 64 + fr, col0 = u.pn * BM + wc * 32 + 4 * fq;
#pragma unroll
        for (int ai = 0; ai < 2; ++ai)
#pragma unroll
            for (int m = 0; m < 4; ++m) {
                const size_t off = (size_t)(row0 + ai * HALF + m * 16) * ldc + col0;
#pragma unroll
                for (int bj = 0; bj < 2; ++bj)
#pragma unroll
                    for (int n = 0; n < 2; ++n) { const u32x2 w = *(const u32x2*)(residb + off + bj * HALF + n * 16);
                        const f32x4 r = {__uint_as_float(w.x << 16), __uint_as_float(w.x & 0xffff0000u), __uint_as_float(w.y << 16), __uint_as_float(w.y & 0xffff0000u)};
                        __builtin_nontemporal_store(r + acc[ai][bj][m][n], (f32x4*)(out + off + bj * HALF + n * 16)); }
            }
    }
};
struct EpiResX1 {
    static constexpr bool PERM = false, AFTER_DRAIN = false, HAS_MID = true; static constexpr int MID_T = 8;
    const bf16_t* residb; const float* invr; bf16_t* xb; float* ssq; int ldc; const float* ssq_a; const float* ssq_b;
    __device__ __forceinline__ void prep(const Unit& u, int ui, PG8_LAS unsigned char* x) const {
        const int tid = threadIdx.x;
        if (tid < 256) { const int row = u.pm * BM + tid; const float ra = __builtin_amdgcn_rsqf(ssq_a[row] * (1.f / 512.f) + 1e-6f), rb = __builtin_amdgcn_rsqf(ssq_b[row] * (1.f / 512.f) + 1e-6f);
            PG8_LAS f32x2* tb = (PG8_LAS f32x2*)(x + 2048 + (ui & 1) * 2048); tb[tid] = (f32x2){ra / rb, rb}; }
    }
    __device__ __forceinline__ void mid(f32x4 (&acc)[2][2][4][2], int ui, int wr, int fr, PG8_LAS unsigned char* x) const {
        const PG8_LAS f32x2* tb = (const PG8_LAS f32x2*)(x + 2048 + (ui & 1) * 2048);
#pragma unroll
        for (int ai = 0; ai < 2; ++ai)
#pragma unroll
            for (int m = 0; m < 4; ++m) { const float q = tb[ai * HALF + wr * 64 + m * 16 + fr].x;
#pragma unroll
                for (int bj = 0; bj < 2; ++bj)
#pragma unroll
                    for (int n = 0; n < 2; ++n) acc[ai][bj][m][n] *= q; }
    }
    __device__ __forceinline__ void fin(const f32x4 (&acc)[2][2][4][2], const Unit& u, int ui, int wr, int wc, int fr, int fq, PG8_LAS unsigned char* x) const {
        const PG8_LAS f32x2* tb = (const PG8_LAS f32x2*)(x + 2048 + (ui & 1) * 2048);
        const int row0 = u.pm * BM + wr * 64 + fr, col0 = u.pn * BM + wc * 32 + 4 * fq;
#pragma unroll
        for (int ai = 0; ai < 2; ++ai)
#pragma unroll
            for (int m = 0; m < 4; ++m) {
                const int row = row0 + ai * HALF + m * 16;
                const float rb = tb[ai * HALF + wr * 64 + m * 16 + fr].y;
                const float ir = invr[row];
                const size_t off = (size_t)row * ldc + col0;
                float s = 0.f;
#pragma unroll
                for (int bj = 0; bj < 2; ++bj)
#pragma unroll
                    for (int n = 0; n < 2; ++n) { const u32x2 xw = *(const u32x2*)(residb + off + bj * HALF + n * 16);
                        const f32x4 xr = {__uint_as_float(xw.x << 16), __uint_as_float(xw.x & 0xffff0000u), __uint_as_float(xw.y << 16), __uint_as_float(xw.y & 0xffff0000u)};
                        const f32x4 v = xr * ir + acc[ai][bj][m][n] * rb;
                        u32x2 w; w.x = cvt_pk_bf16(v[0], v[1]); w.y = cvt_pk_bf16(v[2], v[3]); *(u32x2*)(xb + off + bj * HALF + n * 16) = w;
                        s += (v[0] * v[0] + v[1] * v[1]) + (v[2] * v[2] + v[3] * v[3]); }
                s += __shfl_xor(s, 16); s += __shfl_xor(s, 32);
                if (fq == 0) unsafeAtomicAdd(ssq + row, s);
            }
    }
    __device__ __forceinline__ void operator()(const f32x4 (&acc)[2][2][4][2], const Unit& u, int wr, int wc, int fr, int fq) const {}
};
struct EpiSwiGLU {
    static constexpr bool PERM = true, AFTER_DRAIN = false, HAS_MID = false;
    bf16_t* H; int ldc; const float* ssq; float inv_n;
    __device__ __forceinline__ void operator()(const f32x4 (&acc)[2][2][4][2], const Unit& u, int wr, int wc, int fr, int fq) const {
        const int row0 = u.pm * BM + wr * 64 + fr, col0 = u.pn * HALF + wc * 32 + 8 * fq;
#pragma unroll
        for (int ai = 0; ai < 2; ++ai)
#pragma unroll
            for (int m = 0; m < 4; ++m) {
                float h[8]; const float rs = __builtin_amdgcn_rsqf(ssq[row0 + ai * HALF + m * 16] * inv_n + 1e-6f);
#pragma unroll
                for (int n = 0; n < 2; ++n)
#pragma unroll
                    for (int i = 0; i < 4; ++i) { const float g = acc[ai][0][m][n][i] * rs, up = acc[ai][1][m][n][i] * rs;
                        const float e = __builtin_amdgcn_exp2f(-1.4426950408889634f * g); h[n * 4 + i] = g * __builtin_amdgcn_rcpf(1.0f + e) * up; }
                u32x4 w; w.x = cvt_pk_bf16(h[0], h[1]); w.y = cvt_pk_bf16(h[2], h[3]); w.z = cvt_pk_bf16(h[4], h[5]); w.w = cvt_pk_bf16(h[6], h[7]);
                *(u32x4*)(H + (size_t)(row0 + ai * HALF + m * 16) * ldc + col0) = w;
            }
    }
};

template <class Epi, class Sched, bool ALIGN_EPI = false, bool SP2 = false>
__device__ __forceinline__ void gemm_phase(PG8_LAS unsigned char* lds, const Gemm g, const Sched& S, const Epi& E) {
    const int tid = threadIdx.x, wid = __builtin_amdgcn_readfirstlane(tid >> 6), lane = tid & 63, wr = wid >> 2, wc = wid & 3, fr = lane & 15, fq = lane >> 4;
    const int K = g.K, nt = K / BK;
    unsigned voffA[2], voffB[2];
#pragma unroll
    for (int i = 0; i < 2; ++i) { int R, C; stage_rc(tid * 16 + i * 8192, R, C); const int Rb = Epi::PERM ? ((R & ~31) + perm32(R & 31)) : R;
        voffA[i] = (unsigned)(R * g.lda + C) * 2u; voffB[i] = (unsigned)(Rb * g.ldb + C) * 2u; }
    const size_t kstepA = g.kstepA, kstepB = g.kstepB;
    const size_t hstepA = (size_t)HALF * g.lda * 2, hstepB = (size_t)HALF * g.ldb * 2;
    const size_t tstepA = 2 * hstepA, tstepB = 2 * hstepB;
    const unsigned ldsw = (unsigned)wid * 1024u;
    const int aoff = lds_byte(wr * 64 + fr, fq * 8), boff = lds_byte(wc * 32 + fr, fq * 8);
#define PG8_SA(b, h) (((b) * 2 + (h)) * HTB)
#define PG8_SB(b, h) ((4 + (b) * 2 + (h)) * HTB)
#define PG8_STAGE(bufoff, gbase, voff) do { _Pragma("unroll") for (int _i = 0; _i < 2; ++_i) \
        __builtin_amdgcn_global_load_lds((const unsigned*)((const char*)(gbase) + (voff)[_i]), (PG8_LAS unsigned*)(lds + (bufoff) + ldsw + _i * 8192), 16, 0, 0); } while (0)
#define PG8_LDA(dst, b, h) do { _Pragma("unroll") for (int m = 0; m < 4; ++m) _Pragma("unroll") for (int k = 0; k < 2; ++k) dst[m][k] = *(const PG8_LAS bf16x8*)(lds + PG8_SA(b, h) + aoff + m * 2048 + k * 1024); } while (0)
#define PG8_LDB(dst, b, h) do { _Pragma("unroll") for (int n = 0; n < 2; ++n) _Pragma("unroll") for (int k = 0; k < 2; ++k) dst[n][k] = *(const PG8_LAS bf16x8*)(lds + PG8_SB(b, h) + boff + n * 2048 + k * 1024); } while (0)
#define PG8_MMA(ai, bj, At, Bt) do { __builtin_amdgcn_s_setprio(1); _Pragma("unroll") for (int m = 0; m < 4; ++m) _Pragma("unroll") for (int n = 0; n < 2; ++n) _Pragma("unroll") for (int k = 0; k < 2; ++k) \
        acc[ai][bj][m][n] = __builtin_amdgcn_mfma_f32_16x16x32_bf16(Bt[n][k], At[m][k], acc[ai][bj][m][n], 0, 0, 0); __builtin_amdgcn_s_setprio(0); } while (0)
#define PG8_WAIT_V(n) asm volatile("s_waitcnt vmcnt(" #n ")" ::: "memory")
#define PG8_WAIT_L(n) asm volatile("s_waitcnt lgkmcnt(" #n ")" ::: "memory")
#define PG8_BAR __builtin_amdgcn_s_barrier()
#define PG8_SCHED __builtin_amdgcn_sched_barrier(0)
    Unit cur, nxt; int ui = 0;
    if (!S.next(0, cur)) return;
    f32x4 acc[2][2][4][2];
#pragma unroll
    for (int a = 0; a < 2; ++a)
#pragma unroll
        for (int b = 0; b < 2; ++b)
#pragma unroll
            for (int m = 0; m < 4; ++m)
#pragma unroll
                for (int n = 0; n < 2; ++n) acc[a][b][m][n] = (f32x4){0.f, 0.f, 0.f, 0.f};
    bf16x8 At[4][2], B0[2][2], B1[2][2];
    const char* cA = (const char*)g.A + (size_t)cur.pm * tstepA; const char* cB = (const char*)g.Bt + (size_t)cur.pn * tstepB;
    S.a_ready(cur);
    if constexpr (SP2) {
        PG8_STAGE(PG8_SB(0, 0), cB, voffB); PG8_STAGE(PG8_SB(0, 1), cB + hstepB, voffB); PG8_STAGE(PG8_SA(0, 0), cA, voffA); PG8_STAGE(PG8_SA(0, 1), cA + hstepA, voffA);
        if (wr == 1) PG8_BAR;
        PG8_WAIT_V(2); PG8_BAR;
        PG8_STAGE(PG8_SB(1, 0), cB + kstepB, voffB); PG8_STAGE(PG8_SA(1, 0), cA + kstepA, voffA); PG8_STAGE(PG8_SB(1, 1), cB + hstepB + kstepB, voffB);
        PG8_WAIT_V(6); PG8_BAR;
    } else {
        PG8_STAGE(PG8_SB(0, 0), cB, voffB); PG8_STAGE(PG8_SA(0, 0), cA, voffA); PG8_STAGE(PG8_SB(0, 1), cB + hstepB, voffB); PG8_STAGE(PG8_SA(0, 1), cA + hstepA, voffA);
        if (wr == 1) PG8_BAR;
        PG8_WAIT_V(4); PG8_BAR;
        PG8_STAGE(PG8_SB(1, 0), cB + kstepB, voffB); PG8_STAGE(PG8_SA(1, 0), cA + kstepA, voffA); PG8_STAGE(PG8_SB(1, 1), cB + hstepB + kstepB, voffB);
        PG8_WAIT_V(6); PG8_BAR;
    }
    for (;;) {
        const bool has_next = S.next(ui + 1, nxt);
        if constexpr (Epi::HAS_MID) E.prep(cur, ui, lds + STAGE_BYTES);
        const char* nA = has_next ? (const char*)g.A + (size_t)nxt.pm * tstepA : cA; const char* nB = has_next ? (const char*)g.Bt + (size_t)nxt.pn * tstepB : cB;
        for (int t = 0; t < nt; t += 2) {
            const bool last = (t == nt - 2);
            if constexpr (Epi::HAS_MID) { if (t == Epi::MID_T) E.mid(acc, ui, wr, fr, lds + STAGE_BYTES); }
            const char* a1 = cA + (size_t)(t + 1) * kstepA;
            const char* a2 = last ? nA : cA + (size_t)(t + 2) * kstepA; const char* b2 = last ? nB : cB + (size_t)(t + 2) * kstepB;
            const char* a3 = a2 + kstepA; const char* b3 = b2 + kstepB;
            if (last && has_next) S.a_ready(nxt);
            if constexpr (SP2) {
            PG8_LDB(B0, 0, 0); PG8_LDB(B1, 0, 1); PG8_SCHED; PG8_LDA(At, 0, 0); PG8_STAGE(PG8_SA(1, 1), a1 + hstepA, voffA);
            PG8_WAIT_V(8); PG8_WAIT_L(0); PG8_BAR; PG8_MMA(0, 0, At, B0); PG8_MMA(0, 1, At, B1); PG8_BAR; PG8_SCHED;
            PG8_LDA(At, 0, 1); PG8_STAGE(PG8_SB(0, 0), b2, voffB); PG8_STAGE(PG8_SB(0, 1), b2 + hstepB, voffB); PG8_STAGE(PG8_SA(0, 0), a2, voffA);
            PG8_WAIT_V(8); PG8_WAIT_L(0); PG8_BAR; PG8_MMA(1, 0, At, B0); PG8_MMA(1, 1, At, B1); PG8_BAR; PG8_SCHED;
            PG8_LDB(B0, 1, 0); PG8_LDB(B1, 1, 1); PG8_SCHED; PG8_LDA(At, 1, 0); PG8_STAGE(PG8_SA(0, 1), a2 + hstepA, voffA);
            PG8_WAIT_V(8); PG8_WAIT_L(0); PG8_BAR; PG8_MMA(0, 0, At, B0); PG8_MMA(0, 1, At, B1); PG8_BAR; PG8_SCHED;
            PG8_LDA(At, 1, 1); PG8_STAGE(PG8_SB(1, 0), b3, voffB); PG8_STAGE(PG8_SB(1, 1), b3 + hstepB, voffB); PG8_STAGE(PG8_SA(1, 0), a3, voffA);
            PG8_WAIT_V(8); PG8_WAIT_L(0); PG8_BAR; PG8_MMA(1, 0, At, B0); PG8_MMA(1, 1, At, B1); PG8_BAR; PG8_SCHED;
            } else {
            PG8_LDB(B0, 0, 0); PG8_SCHED; PG8_LDA(At, 0, 0); PG8_STAGE(PG8_SA(1, 1), a1 + hstepA, voffA);
            PG8_WAIT_L(8); PG8_BAR; PG8_WAIT_L(0); PG8_MMA(0, 0, At, B0); PG8_BAR; PG8_SCHED;
            PG8_LDB(B1, 0, 1); PG8_STAGE(PG8_SB(0, 0), b2, voffB);
            PG8_BAR; PG8_WAIT_L(0); PG8_MMA(0, 1, At, B1); PG8_BAR;
            PG8_LDA(At, 0, 1); PG8_STAGE(PG8_SA(0, 0), a2, voffA);
            PG8_BAR; PG8_WAIT_L(0); PG8_MMA(1, 0, At, B0); PG8_BAR; PG8_SCHED;
            PG8_STAGE(PG8_SB(0, 1), b2 + hstepB, voffB);
            PG8_WAIT_V(6); PG8_BAR; PG8_MMA(1, 1, At, B1); PG8_BAR;
            PG8_LDB(B0, 1, 0); PG8_SCHED; PG8_LDA(At, 1, 0); PG8_STAGE(PG8_SA(0, 1), a2 + hstepA, voffA);
            PG8_WAIT_L(8); PG8_BAR; PG8_WAIT_L(0); PG8_MMA(0, 0, At, B0); PG8_BAR; PG8_SCHED;
            PG8_LDB(B1, 1, 1); PG8_STAGE(PG8_SB(1, 0), b3, voffB);
            PG8_BAR; PG8_WAIT_L(0); PG8_MMA(0, 1, At, B1); PG8_BAR;
            PG8_LDA(At, 1, 1); PG8_STAGE(PG8_SA(1, 0), a3, voffA);
            PG8_BAR; PG8_WAIT_L(0); PG8_MMA(1, 0, At, B0); PG8_BAR; PG8_SCHED;
            PG8_STAGE(PG8_SB(1, 1), b3 + hstepB, voffB);
            PG8_WAIT_V(6); PG8_BAR; PG8_MMA(1, 1, At, B1); PG8_BAR;
            }
        }
        if constexpr (ALIGN_EPI) { if (wr == 0) PG8_BAR; }
        if constexpr (!Epi::AFTER_DRAIN) { if constexpr (Epi::HAS_MID) E.fin(acc, cur, ui, wr, wc, fr, fq, lds + STAGE_BYTES); else E(acc, cur, wr, wc, fr, fq); S.done(cur); }
        if (!has_next) break;
#pragma unroll
        for (int a = 0; a < 2; ++a)
#pragma unroll
            for (int b = 0; b < 2; ++b)
#pragma unroll
                for (int m = 0; m < 4; ++m)
#pragma unroll
                    for (int n = 0; n < 2; ++n) acc[a][b][m][n] = (f32x4){0.f, 0.f, 0.f, 0.f};
        cur = nxt; cA = nA; cB = nB; ++ui;
        if constexpr (ALIGN_EPI) { if (wr == 1) PG8_BAR; }
    }
    PG8_WAIT_V(0);
    if constexpr (!ALIGN_EPI) { if (wr == 0) PG8_BAR; }
    PG8_BAR;
    if constexpr (Epi::AFTER_DRAIN) { E.fused(acc, cur, wr, wc, fr, fq, lds, wid, lane); S.done(cur); }
#undef PG8_SA
#undef PG8_SB
#undef PG8_STAGE
#undef PG8_LDA
#undef PG8_LDB
#undef PG8_MMA
#undef PG8_WAIT_V
#undef PG8_WAIT_L
#undef PG8_BAR
#undef PG8_SCHED
}
}

#define LAS __attribute__((address_space(3)))
typedef unsigned short bf16_t;
typedef short bf16x8 __attribute__((ext_vector_type(8)));
typedef float f32x4 __attribute__((ext_vector_type(4)));
typedef float f32x16 __attribute__((ext_vector_type(16)));
typedef unsigned u32x4 __attribute__((ext_vector_type(4)));
typedef unsigned u32x2 __attribute__((ext_vector_type(2)));
using pg8::cvt_pk_bf16;

constexpr int NB = 16, SEQ = 2048, T = NB * SEQ, DM = 1024, GRID_W = 64;
constexpr int NP = 1536;
constexpr int C_CQ = 0, C_CKV = 384, C_KPE = 640, C_GQ = 672, C_GK = 1184, C_GV = 1312, C_END = 1440;
constexpr int DFF = 2816;
constexpr float EPS = 1e-6f;
constexpr float LOG2E = 1.4426950408889634f;
constexpr float LOG2_THETA = 13.287712379549449f;
constexpr int NWAVES = 8, NTHREADS = 512;

constexpr size_t MiB = 1u << 20;
constexpr size_t WS_SSQ_X1 = 64 * 1024, WS_SSQ_CQ = 192 * 1024, WS_SSQ_CKV = 320 * 1024, WS_SSQ_OA = 448 * 1024, WS_SSQ_OB = 576 * 1024;
constexpr size_t WS_X1B = 320 * MiB;
constexpr size_t WS_WIN = 1 * MiB;
constexpr size_t WS_WQB = 4 * MiB;
constexpr size_t WS_WKV = 5 * MiB;
constexpr size_t WS_WO = 6 * MiB;
constexpr size_t WS_WGU = 8 * MiB;
constexpr size_t WS_WD = 19 * MiB;
constexpr size_t WS_XB = 32 * MiB;
constexpr size_t WS_P = 96 * MiB;
constexpr size_t WS_QAR = 192 * MiB;
constexpr size_t WS_KNR = 240 * MiB;
constexpr size_t WS_H = 96 * MiB;
constexpr size_t WS_VTA = 272 * MiB;
constexpr size_t WS_VTB = 304 * MiB;
constexpr size_t WS_QA = 320 * MiB;
constexpr size_t WS_KA = 368 * MiB;
constexpr size_t WS_QB = 416 * MiB;
constexpr size_t WS_KB = 416 * MiB;
constexpr size_t WS_O = 424 * MiB;
constexpr size_t WS_INVR1 = 26 * MiB;
constexpr size_t WS_END = 488 * MiB;

static_assert(WS_P == WSC_P && WS_QAR == WSC_QAR && WS_KNR == WSC_KNR && WS_H == WSC_H && WS_VTA == WSC_VTA && WS_VTB == WSC_VTB && WS_X1B == WSC_X1B && WS_SSQ_X1 == WSC_SSQ_X1 && WS_SSQ_CQ == WSC_SSQ_CQ && WS_SSQ_CKV == WSC_SSQ_CKV && WS_SSQ_OA == WSC_SSQ_OA && WS_SSQ_OB == WSC_SSQ_OB, "d_ws map");
constexpr int LDS_BYTES = 131072 + 8192;

struct Args { const float* in[18]; float* out; unsigned char* ws; int ph_lo, ph_hi; };

__device__ __forceinline__ float wave_sum(float v) {
#pragma unroll
    for (int o = 1; o < 64; o <<= 1) v += __shfl_xor(v, o);
    return v;
}
__device__ __forceinline__ float bf2f(unsigned short h) { return __uint_as_float((unsigned)h << 16); }
__device__ __forceinline__ void unpack8(const u32x4 w, float* f) {
    f[0] = __uint_as_float(w.x << 16); f[1] = __uint_as_float(w.x & 0xffff0000u); f[2] = __uint_as_float(w.y << 16); f[3] = __uint_as_float(w.y & 0xffff0000u);
    f[4] = __uint_as_float(w.z << 16); f[5] = __uint_as_float(w.z & 0xffff0000u); f[6] = __uint_as_float(w.w << 16); f[7] = __uint_as_float(w.w & 0xffff0000u);
}
__device__ __forceinline__ u32x4 pack8(const float* f) { u32x4 w; w.x = cvt_pk_bf16(f[0], f[1]); w.y = cvt_pk_bf16(f[2], f[3]); w.z = cvt_pk_bf16(f[4], f[5]); w.w = cvt_pk_bf16(f[6], f[7]); return w; }

__device__ __forceinline__ void transpose_item(const float* W, int ldw, int k0, int n_src0, bf16_t* WT, int ldt, int dst_row0, const float* gain, LAS float* scr, int lane) {
    float v[32];
    const float* wp = W + (size_t)(k0 + (lane >> 5)) * ldw + n_src0 + (lane & 31);
#pragma unroll
    for (int i = 0; i < 32; ++i) v[i] = __builtin_nontemporal_load(wp + (size_t)(2 * i) * ldw);
    const int c = lane & 7;
    float g[8];
    if (gain) {
        const f32x4 g0 = *(const f32x4*)(gain + k0 + 8 * c), g1 = *(const f32x4*)(gain + k0 + 8 * c + 4);
        g[0] = g0.x; g[1] = g0.y; g[2] = g0.z; g[3] = g0.w; g[4] = g1.x; g[5] = g1.y; g[6] = g1.z; g[7] = g1.w;
    } else {
#pragma unroll
        for (int j = 0; j < 8; ++j) g[j] = 1.0f;
    }
#pragma unroll
    for (int i = 0; i < 32; ++i) scr[(2 * i + (lane >> 5)) * 33 + (lane & 31)] = v[i];
    asm volatile("s_waitcnt lgkmcnt(0)" ::: "memory");
#pragma unroll
    for (int j = 0; j < 4; ++j) { const int n = (lane >> 3) + 8 * j; const LAS float* s = scr + (8 * c) * 33 + n;
        u32x4 o; o.x = cvt_pk_bf16(s[0 * 33] * g[0], s[1 * 33] * g[1]); o.y = cvt_pk_bf16(s[2 * 33] * g[2], s[3 * 33] * g[3]);
        o.z = cvt_pk_bf16(s[4 * 33] * g[4], s[5 * 33] * g[5]); o.w = cvt_pk_bf16(s[6 * 33] * g[6], s[7 * 33] * g[7]);
        *(u32x4*)(WT + (size_t)(dst_row0 + n) * ldt + k0 + 8 * c) = o; }
    asm volatile("s_waitcnt lgkmcnt(0)" ::: "memory");
}

__device__ __forceinline__ void phase_prologue(const Args& a, LAS unsigned char* lds, int vcu, int G, int wave, int lane) {
    unsigned char* ws = a.ws;
    LAS float* scr = (LAS float*)(lds + wave * 16384);
    const int gw = vcu * NWAVES + wave, NGW = G * NWAVES;
    bf16_t* WinT = (bf16_t*)(ws + WS_WIN); bf16_t* WqbT = (bf16_t*)(ws + WS_WQB); bf16_t* WkvT = (bf16_t*)(ws + WS_WKV);
    bf16_t* WoT = (bf16_t*)(ws + WS_WO); bf16_t* WguT = (bf16_t*)(ws + WS_WGU); bf16_t* WdT = (bf16_t*)(ws + WS_WD);
    constexpr int I0 = 16 * 45, I1 = 6 * 24, I2 = 4 * 32, I3 = 16 * 32, I4 = 16 * 88, I5 = 16 * 88, I6 = 44 * 32;
    constexpr int NITEMS = I0 + I1 + I2 + I3 + I4 + I5 + I6;
    for (int pass = 0; pass < 2; ++pass) {
    if ((pass == 0) == ((wave & 1) == 0)) {
    for (int it = gw; it < NITEMS; it += NGW) {
        int r = it;
        if (r < I0) { const int kb = r / 45, nb = r % 45; const int n0 = nb * 32;
            int dr = n0; if (n0 >= 1184) { const int k = (n0 - 1184) & 127, isv = (n0 >= 1312) ? 2 : 0; dr = 1280 + ((k >> 5) & 1) * 128 + (isv + (k >> 6)) * 32; }
            transpose_item(a.in[2], 1440, kb * 64, n0, WinT, 1024, dr, a.in[1], scr, lane); continue; } r -= I0;
        if (r < I1) { const int kb = r / 24, nb = r % 24; transpose_item(a.in[4], 768, kb * 64, nb * 32, WqbT, 384, nb * 32, a.in[3], scr, lane); continue; } r -= I1;
        if (r < I2) { const int kb = r / 32, nb = r % 32; const int head = nb >> 2, part = (nb >> 1) & 1, half = nb & 1;
            transpose_item(a.in[6], 1024, kb * 64, nb * 32, WkvT, 256, 256 * (head >> 1) + 128 * half + 32 * (2 * (head & 1) + part), a.in[5], scr, lane); continue; } r -= I2;
        if (r < I3) { const int kb = r / 32, nb = r % 32; const float* g = (kb < 8) ? a.in[11] : (a.in[12] - 512); transpose_item(a.in[13], 1024, kb * 64, nb * 32, WoT, 1024, nb * 32, g, scr, lane); continue; } r -= I3;
        if (r < I4) { const int kb = r / 88, nb = r % 88; const int n0 = nb * 32; transpose_item(a.in[15], DFF, kb * 64, n0, WguT, 1024, 256 * (n0 >> 7) + (n0 & 127), a.in[14], scr, lane); continue; } r -= I4;
        if (r < I5) { const int kb = r / 88, nb = r % 88; const int n0 = nb * 32; transpose_item(a.in[16], DFF, kb * 64, n0, WguT, 1024, 256 * (n0 >> 7) + 128 + (n0 & 127), a.in[14], scr, lane); continue; } r -= I5;
        { const int kb = r / 32, nb = r % 32; transpose_item(a.in[17], 1024, kb * 64, nb * 32, WdT, DFF, nb * 32, nullptr, scr, lane); }
    }
    for (int i = gw * 64 + lane; i < 96 * 128; i += NGW * 64) ((u32x4*)(WinT + (size_t)1184 * 1024))[i] = (u32x4){0u, 0u, 0u, 0u};
    } else {
    bf16_t* xb = (bf16_t*)(ws + WS_XB);
    for (int m0 = gw; m0 < T; m0 += 4 * NGW) {
        f32x4 v[4][4];
#pragma unroll
        for (int r = 0; r < 4; ++r) { const int m = m0 + r * NGW; if (m < T) { const f32x4* xr = (const f32x4*)(a.in[0] + (size_t)m * DM) + lane;
#pragma unroll
            for (int j = 0; j < 4; ++j) v[r][j] = __builtin_nontemporal_load(xr + 64 * j); } }
#pragma unroll
        for (int r = 0; r < 4; ++r) { const int m = m0 + r * NGW; if (m < T) {
            float s = 0.f;
#pragma unroll
            for (int j = 0; j < 4; ++j) s += (v[r][j].x * v[r][j].x + v[r][j].y * v[r][j].y) + (v[r][j].z * v[r][j].z + v[r][j].w * v[r][j].w);
            const float rt = sqrtf(wave_sum(s) * (1.f / DM) + EPS), rstd = 1.0f / rt;
            if (lane == 0) ((float*)(ws + WS_INVR1))[m] = rt;
            u32x2* o8 = (u32x2*)(xb + (size_t)m * DM) + lane;
#pragma unroll
            for (int j = 0; j < 4; ++j) { u32x2 w; w.x = cvt_pk_bf16(v[r][j].x * rstd, v[r][j].y * rstd); w.y = cvt_pk_bf16(v[r][j].z * rstd, v[r][j].w * rstd); o8[64 * j] = w; } } }
    }
    }
    }
}

__device__ __forceinline__ float max3f(float a, float b, float c) { return __builtin_fmaxf(__builtin_fmaxf(a, b), c); }
template <int DQK>
__device__ __forceinline__ void attn_unit(const bf16_t* Qg, int qpitch, const float* gq, int spos0, const bf16_t* Kg, const bf16_t* Vg, bf16_t* Og, float* ssq, LAS unsigned char* lds, int tid, int wid, int lane) {
    constexpr int KST = DQK * 2 + 16, VST = 144, KBUF = 64 * KST, VBUF = 64 * VST, ND = DQK / 16, CPR = DQK / 8, NCH = 64 * CPR, NT = SEQ / 64;
    constexpr float THR = 8.0f;
    constexpr int NPRE = (DQK == 96) ? ND / 2 : ND; constexpr int NKS = (NPRE < ND) ? 3 : 2;
    constexpr bool NEGM = true;
    const int r32 = lane & 31, hi = lane >> 5;
    bf16x8 qr[ND];
    {
        int r32p = r32, hip = hi; asm volatile("" : "+v"(r32p), "+v"(hip));
        const int spos = spos0 + wid * 32 + r32p;
        asm volatile("" : "+s"(gq));
        const bf16_t* qrow = Qg + (size_t)(wid * 32 + r32p) * qpitch + hip * 8;
        u32x4 raw[ND]; float ss = 0.f;
#pragma unroll
        for (int d0 = 0; d0 < ND; ++d0) raw[d0] = *(const u32x4*)(qrow + d0 * 16);
#pragma unroll
        for (int d0 = 0; d0 < ND; ++d0) { float f[8]; unpack8(raw[d0], f);
#pragma unroll
            for (int j = 0; j < 8; ++j) ss += f[j] * f[j]; }
        ss += __shfl_xor(ss, 32);
        const float qs = (DQK == 96 ? 0.10206207261596577f : 0.125f) * LOG2E;
        const float rs = qs / sqrtf(ss * (1.0f / DQK) + EPS);
        const float prow = (float)(spos >> 6), pcol = (float)(spos & 63);
        constexpr int NPLAIN = (DQK == 96) ? ND - 2 : 0;
#pragma unroll
        for (int d0 = 0; d0 < NPLAIN; ++d0) { float f[8]; unpack8(raw[d0], f);
            const f32x4 g0 = *(const f32x4*)(gq + d0 * 16 + hip * 8), g1 = *(const f32x4*)(gq + d0 * 16 + hip * 8 + 4);
            f[0] *= rs * g0.x; f[1] *= rs * g0.y; f[2] *= rs * g0.z; f[3] *= rs * g0.w; f[4] *= rs * g1.x; f[5] *= rs * g1.y; f[6] *= rs * g1.z; f[7] *= rs * g1.w;
            qr[d0] = __builtin_bit_cast(bf16x8, pack8(f)); }
        if (DQK == 96) {
#pragma unroll
            for (int part = 0; part < 2; ++part) { const int d0 = ND - 2 + part; float f[8]; unpack8(raw[d0], f);
                const f32x4 g0 = *(const f32x4*)(gq + d0 * 16 + hip * 8), g1 = *(const f32x4*)(gq + d0 * 16 + hip * 8 + 4);
                f[0] *= rs * g0.x; f[1] *= rs * g0.y; f[2] *= rs * g0.z; f[3] *= rs * g0.w; f[4] *= rs * g1.x; f[5] *= rs * g1.y; f[6] *= rs * g1.z; f[7] *= rs * g1.w;
#pragma unroll
                for (int j = 0; j < 8; ++j) { const float ang = (part ? pcol : prow) * __builtin_amdgcn_exp2f(-(float)j * (LOG2_THETA / 8.0f)), c = __cosf(ang), sn = __sinf(ang);
                    const float y = f[j], py = __shfl_xor(y, 32); f[j] = hip ? (py * sn + y * c) : (y * c - py * sn); }
                qr[d0] = __builtin_bit_cast(bf16x8, pack8(f)); }
        } else {
#pragma unroll
            for (int part = 0; part < 2; ++part) { float f1[8], f2[8]; unpack8(raw[2 * part], f1); unpack8(raw[2 * part + 1], f2);
                const float* ga = gq + (2 * part) * 16 + hip * 8; const float* gb = gq + (2 * part + 1) * 16 + hip * 8;
#pragma unroll
                for (int j = 0; j < 8; ++j) { const float ang = (part ? pcol : prow) * __builtin_amdgcn_exp2f(-(float)(8 * hip + j) * (LOG2_THETA / 16.0f)), c = __cosf(ang), sn = __sinf(ang);
                    const float x1 = f1[j] * rs * ga[j], x2 = f2[j] * rs * gb[j]; f1[j] = x1 * c - x2 * sn; f2[j] = x1 * sn + x2 * c; }
                qr[2 * part] = __builtin_bit_cast(bf16x8, pack8(f1)); qr[2 * part + 1] = __builtin_bit_cast(bf16x8, pack8(f2)); }
        }
    }
    __builtin_amdgcn_sched_barrier(0);
    const int kl0 = (tid / CPR) * KST + (tid % CPR) * 16;
    const int kl1 = ((tid + 512) / CPR) * KST + ((tid + 512) % CPR) * 16;
    const bool has1 = (NCH > 512) && (tid + 512 < NCH);
    const int vd = tid >> 3, vc = tid & 7;
    const int vl = vd * VST + (16 * (vc >> 1) + 4 * (vc & 1)) * 2;
    const bf16_t* vsrc = Vg + (size_t)vd * T + vc * 8;
    const int kfo = r32 * KST + hi * 16, vfo = r32 * VST + hi * 16;
    u32x4 kreg0, kreg1 = (u32x4){0u, 0u, 0u, 0u}, vreg;
#define AT_GLOADK(t) do { const u32x4* kp_ = (const u32x4*)(Kg + (size_t)(t) * 64 * DQK); kreg0 = kp_[tid]; if (has1) kreg1 = kp_[tid + 512]; } while (0)
#define AT_GLOADV(t) do { vreg = *(const u32x4*)(vsrc + (t) * 64); } while (0)
#define AT_LSTOREK(buf) do { LAS unsigned char* kb_ = lds + (buf) * KBUF; *(LAS u32x4*)(kb_ + kl0) = kreg0; if (has1) *(LAS u32x4*)(kb_ + kl1) = kreg1; } while (0)
#define AT_LSTOREV(buf) do { LAS unsigned char* vb_ = lds + NKS * KBUF + (buf) * VBUF; *(LAS u32x2*)(vb_ + vl) = (u32x2){vreg.x, vreg.y}; *(LAS u32x2*)(vb_ + vl + 16) = (u32x2){vreg.z, vreg.w}; } while (0)
#define AT_BAR() do { asm volatile("s_waitcnt lgkmcnt(0)" ::: "memory"); __builtin_amdgcn_s_barrier(); asm volatile("" ::: "memory"); } while (0)
    float m = 0.f, l = 0.f;
    f32x16 negm;
    f32x16 o0, o1, s0, s1;
    bf16x8 pb[4];
#pragma unroll
    for (int r = 0; r < 16; ++r) { o0[r] = 0.f; o1[r] = 0.f; s0[r] = 0.f; s1[r] = 0.f; negm[r] = 0.f; }
    asm volatile("" : "+v"(negm));
#pragma unroll
    for (int g = 0; g < 4; ++g) pb[g] = (bf16x8){0, 0, 0, 0, 0, 0, 0, 0};
    bf16x8 kf[2 * ND], vf[8];
#define AT_KREADH(slot, lo_, hi_) do { const LAS unsigned char* Kb_ = lds + (slot) * KBUF + kfo; \
        _Pragma("unroll") for (int d0 = (lo_); d0 < (hi_); ++d0) { kf[2 * d0] = *(const LAS bf16x8*)(Kb_ + d0 * 32); kf[2 * d0 + 1] = *(const LAS bf16x8*)(Kb_ + 32 * KST + d0 * 32); } } while (0)
#define AT_KREAD(slot) AT_KREADH(slot, 0, NPRE)
#define AT_VREAD(slot) do { const LAS unsigned char* Vb_ = lds + NKS * KBUF + (slot) * VBUF + vfo; \
        _Pragma("unroll") for (int g = 0; g < 4; ++g) { vf[2 * g] = *(const LAS bf16x8*)(Vb_ + g * 32); vf[2 * g + 1] = *(const LAS bf16x8*)(Vb_ + 32 * VST + g * 32); } } while (0)
#define AT_QKH(lo_, hi_) do { \
        _Pragma("unroll") for (int d0 = (lo_); d0 < (hi_); ++d0) { \
            if (d0 == 0) { s0 = __builtin_amdgcn_mfma_f32_32x32x16_bf16(kf[0], qr[0], negm, 0, 0, 0); s1 = __builtin_amdgcn_mfma_f32_32x32x16_bf16(kf[1], qr[0], negm, 0, 0, 0); } \
            else { s0 = __builtin_amdgcn_mfma_f32_32x32x16_bf16(kf[2 * d0], qr[d0], s0, 0, 0, 0); s1 = __builtin_amdgcn_mfma_f32_32x32x16_bf16(kf[2 * d0 + 1], qr[d0], s1, 0, 0, 0); } } } while (0)
#define AT_SZERO() do { } while (0)
#define AT_PV() do { \
        _Pragma("unroll") for (int g = 0; g < 4; ++g) { \
            o0 = __builtin_amdgcn_mfma_f32_32x32x16_bf16(vf[2 * g], pb[g], o0, 0, 0, 0); \
            o1 = __builtin_amdgcn_mfma_f32_32x32x16_bf16(vf[2 * g + 1], pb[g], o1, 0, 0, 0); } } while (0)
#define AT_SOFTMAX(first_) do { \
        float ta_ = max3f(s0[0], s0[1], s0[2]), tb_ = max3f(s1[0], s1[1], s1[2]); \
        _Pragma("unroll") for (int r = 3; r < 15; r += 2) { ta_ = max3f(ta_, s0[r], s0[r + 1]); tb_ = max3f(tb_, s1[r], s1[r + 1]); } \
        float tm_ = max3f(ta_, tb_, fmaxf(s0[15], s1[15])); \
        { auto rr_ = __builtin_amdgcn_permlane32_swap(__float_as_uint(tm_), __float_as_uint(tm_), false, false); tm_ = fmaxf(__uint_as_float(rr_[0]), __uint_as_float(rr_[1])); } \
        if (!NEGM) tm_ -= m; \
        if ((first_) || __any(tm_ > THR)) { const float dl_ = (first_) ? tm_ : fmaxf(tm_, 0.f), al_ = (first_) ? 1.0f : __builtin_amdgcn_exp2f(-dl_); \
            m += dl_; l *= al_; \
            _Pragma("unroll") for (int r = 0; r < 16; ++r) { o0[r] *= al_; o1[r] *= al_; } \
            if (NEGM) { _Pragma("unroll") for (int r = 0; r < 16; ++r) { s0[r] -= dl_; s1[r] -= dl_; negm[r] = -m; } asm volatile("" : "+v"(negm)); } } \
        if (!NEGM) { _Pragma("unroll") for (int r = 0; r < 16; ++r) { s0[r] -= m; s1[r] -= m; } } \
        float ps_ = 0.f; \
        _Pragma("unroll") for (int r = 0; r < 16; ++r) { s0[r] = __builtin_amdgcn_exp2f(s0[r]); s1[r] = __builtin_amdgcn_exp2f(s1[r]); ps_ += s0[r] + s1[r]; } \
        l += ps_; \
        u32x4 w_; \
        w_.x = cvt_pk_bf16(s0[0], s0[1]); w_.y = cvt_pk_bf16(s0[2], s0[3]); w_.z = cvt_pk_bf16(s0[4], s0[5]); w_.w = cvt_pk_bf16(s0[6], s0[7]); pb[0] = __builtin_bit_cast(bf16x8, w_); \
        w_.x = cvt_pk_bf16(s0[8], s0[9]); w_.y = cvt_pk_bf16(s0[10], s0[11]); w_.z = cvt_pk_bf16(s0[12], s0[13]); w_.w = cvt_pk_bf16(s0[14], s0[15]); pb[1] = __builtin_bit_cast(bf16x8, w_); \
        w_.x = cvt_pk_bf16(s1[0], s1[1]); w_.y = cvt_pk_bf16(s1[2], s1[3]); w_.z = cvt_pk_bf16(s1[4], s1[5]); w_.w = cvt_pk_bf16(s1[6], s1[7]); pb[2] = __builtin_bit_cast(bf16x8, w_); \
        w_.x = cvt_pk_bf16(s1[8], s1[9]); w_.y = cvt_pk_bf16(s1[10], s1[11]); w_.z = cvt_pk_bf16(s1[12], s1[13]); w_.w = cvt_pk_bf16(s1[14], s1[15]); pb[3] = __builtin_bit_cast(bf16x8, w_); } while (0)
    AT_GLOADK(0); AT_GLOADV(0); AT_LSTOREK(0); AT_LSTOREV(0);
    AT_GLOADK(1); AT_LSTOREK(1);
    AT_BAR();
    AT_KREAD(0);
    int ks_cur = 0, ks_next = 1, ks_st = (NKS == 3) ? 2 : 0;
    for (int t = 0; t < NT; ++t) {
        if (t + 2 < NT) AT_GLOADK(t + 2);
        if (t + 1 < NT) AT_GLOADV(t + 1);
        if (NPRE < ND) AT_KREADH(ks_cur, NPRE, ND);
        AT_SZERO();
        AT_QKH(0, ND);
        __builtin_amdgcn_sched_barrier(0);
        AT_VREAD(t & 1);
        __builtin_amdgcn_sched_barrier(0);
        AT_SOFTMAX(t == 0);
        __builtin_amdgcn_sched_barrier(0);
        if (t + 1 < NT) AT_KREAD(ks_next);
        __builtin_amdgcn_sched_barrier(0);
        AT_PV();
        if (t + 2 < NT) AT_LSTOREK(ks_st);
        if (t + 1 < NT) AT_LSTOREV((t + 1) & 1);
        AT_BAR();
        { const int c_ = ks_cur; ks_cur = ks_next; ks_next = ks_st; ks_st = (NKS == 3) ? c_ : ks_cur; }
    }
#undef AT_BAR
#undef AT_GLOADK
#undef AT_GLOADV
#undef AT_LSTOREK
#undef AT_LSTOREV
#undef AT_QKH
#undef AT_SZERO
#undef AT_KREAD
#undef AT_KREADH
#undef AT_VREAD
#undef AT_PV
#undef AT_SOFTMAX
    l += __shfl_xor(l, 32);
    const float il = 1.0f / l;
    {
        float sq = 0.f;
#pragma unroll
        for (int r = 0; r < 16; ++r) { const float a0 = o0[r] * il, a1 = o1[r] * il; sq += a0 * a0 + a1 * a1; }
        sq += __shfl_xor(sq, 32);
        if (hi == 0) unsafeAtomicAdd(ssq + wid * 32 + r32, sq);
    }
    bf16_t* orow = Og + (size_t)(wid * 32 + r32) * DM + 8 * hi;
#pragma unroll
    for (int db = 0; db < 2; ++db)
#pragma unroll
        for (int pr = 0; pr < 2; ++pr) {
            const int ra = 8 * pr, rb = 8 * pr + 4;
            unsigned ax, ay, bx_, by;
            if (db == 0) { ax = cvt_pk_bf16(o0[ra] * il, o0[ra + 1] * il); ay = cvt_pk_bf16(o0[ra + 2] * il, o0[ra + 3] * il); bx_ = cvt_pk_bf16(o0[rb] * il, o0[rb + 1] * il); by = cvt_pk_bf16(o0[rb + 2] * il, o0[rb + 3] * il); }
            else         { ax = cvt_pk_bf16(o1[ra] * il, o1[ra + 1] * il); ay = cvt_pk_bf16(o1[ra + 2] * il, o1[ra + 3] * il); bx_ = cvt_pk_bf16(o1[rb] * il, o1[rb + 1] * il); by = cvt_pk_bf16(o1[rb + 2] * il, o1[rb + 3] * il); }
            const auto sx = __builtin_amdgcn_permlane32_swap(ax, bx_, false, false), sy = __builtin_amdgcn_permlane32_swap(ay, by, false, false);
            u32x4 w; w.x = sx[0]; w.y = sy[0]; w.z = sx[1]; w.w = sy[1];
            *(u32x4*)(orow + 32 * db + 16 * pr) = w;
        }
}

__device__ __forceinline__ void phase_attn(const Args& a, LAS unsigned char* lds, int vcu, int G, int tid, int wid, int lane) {
    unsigned char* ws = a.ws;
    const bf16_t* QAR = (const bf16_t*)(ws + WS_QAR); const bf16_t* Pq = (const bf16_t*)(ws + WS_P); const bf16_t* Ka = (const bf16_t*)(ws + WS_KA); const bf16_t* Vta = (const bf16_t*)(ws + WS_VTA);
    const bf16_t* Kb = (const bf16_t*)(ws + WS_KB); const bf16_t* Vtb = (const bf16_t*)(ws + WS_VTB);
    bf16_t* O = (bf16_t*)(ws + WS_O);
    const int flip = (G == 256) ? (((vcu >> 5) & 1) << 10) : 0;
    for (int u0 = vcu; u0 < 2048; u0 += G) {
        const int u = u0 ^ flip;
        const int grp = u >> 10, id = u & 1023, qb = id & 7, bh = id >> 3, b = bh >> 3, h = bh & 7;
        if (grp == 0) {
            attn_unit<96>(QAR + ((size_t)b * SEQ + qb * 256) * 768 + h * 96, 768, a.in[7], qb * 256, Ka + (size_t)bh * SEQ * 96, Vta + (size_t)(h * 64) * T + (size_t)b * SEQ,
                          O + ((size_t)b * SEQ + qb * 256) * DM + h * 64, (float*)(ws + WS_SSQ_OA) + (size_t)b * SEQ + qb * 256, lds, tid, wid, lane);
        } else {
            const int hk = h >> 2;
            attn_unit<64>(Pq + ((size_t)b * SEQ + qb * 256) * NP + C_GQ + h * 64, NP, a.in[9], qb * 256, Kb + (size_t)(b * 2 + hk) * SEQ * 64, Vtb + (size_t)(hk * 64) * T + (size_t)b * SEQ,
                          O + ((size_t)b * SEQ + qb * 256) * DM + 512 + h * 64, (float*)(ws + WS_SSQ_OB) + (size_t)b * SEQ + qb * 256, lds, tid, wid, lane);
        }
    }
}

#define XB_TMO      128
#define XB_XCNT(j)  (256  + 64 * (j))
#define XB_XSUB(j)  (1280 + 64 * (j))
#define XB_XGEN(j)  (2304 + 64 * (j))
#define XB_TOP      3328
#define XB_TOPGEN   3392
#define XCD_BAR_WORDS 3456
#define XB_SPIN_CAP (1u << 18)

__device__ __forceinline__ unsigned xb_ld(unsigned* p)              { return __hip_atomic_load(p, __ATOMIC_RELAXED, __HIP_MEMORY_SCOPE_AGENT); }
__device__ __forceinline__ unsigned xb_add(unsigned* p, unsigned v) { return __hip_atomic_fetch_add(p, v, __ATOMIC_RELAXED, __HIP_MEMORY_SCOPE_AGENT); }
__device__ __forceinline__ unsigned xb_xcc_id() { return (unsigned)__builtin_amdgcn_s_getreg((3 << 11) | 20) & 0xFu; }
#define XB_SPIN(cond, bar) do { unsigned _sp = 0; while (cond) { \
    if ((++_sp & 255u) == 0u) { if (xb_ld(&(bar)[XB_TMO])) break; if (_sp > XB_SPIN_CAP) { atomicAdd(&(bar)[XB_TMO], 1u); break; } } } } while (0)

struct XcdBarrier {
    unsigned* bar; unsigned x;
    volatile LAS unsigned* st;
};

__device__ __forceinline__ XcdBarrier xcd_barrier_post(unsigned* bar, volatile LAS unsigned* st) {
    XcdBarrier b; b.bar = bar; b.x = xb_xcc_id(); b.st = st;
    if (threadIdx.x == 0) (void)xb_add(&bar[XB_XCNT(b.x)], 1u);
    return b;
}
__device__ __forceinline__ void xcd_barrier_complete(unsigned* bar, unsigned x, unsigned& nloc, unsigned& nx) {
    const unsigned G = gridDim.x * gridDim.y * gridDim.z;
    unsigned sum, cnt, mine, sp = 0u;
    for (;;) {
        sum = 0u; cnt = 0u; mine = 0u;
#pragma unroll
        for (unsigned j = 0; j < 16; ++j) { const unsigned c = xb_ld(&bar[XB_XCNT(j)]); sum += c; cnt += (c > 0u) ? 1u : 0u; mine = (j == x) ? c : mine; }
        if (sum == G) break;
        __builtin_amdgcn_s_sleep(1);
        if ((++sp & 255u) == 0u) { if (xb_ld(&bar[XB_TMO])) break; if (sp > XB_SPIN_CAP) { atomicAdd(&bar[XB_TMO], 1u); break; } }
    }
    nloc = mine > 0u ? mine : 1u; nx = cnt > 0u ? cnt : 1u;
}

__device__ __forceinline__ void xcd_barrier(const XcdBarrier& b) {
    asm volatile("s_waitcnt vmcnt(0)" ::: "memory");
    __syncthreads();
    if (threadIdx.x == 0) {
        unsigned* bar = b.bar;
        __builtin_amdgcn_s_waitcnt(0);
        unsigned nloc = b.st[0], nx = b.st[1];
        if (nloc == 0u) { xcd_barrier_complete(bar, b.x, nloc, nx); b.st[0] = nloc; b.st[1] = nx; }
        const unsigned old = xb_add(&bar[XB_XSUB(b.x)], 1u);
        const unsigned gen = old / nloc;
        if (old + 1u == (gen + 1u) * nloc) {
            __builtin_amdgcn_fence(__ATOMIC_RELEASE, "agent");
            asm volatile("s_waitcnt vmcnt(0)" ::: "memory");
            const unsigned og = xb_add(&bar[XB_TOP], 1u);
            const unsigned tg = og / nx;
            if (og + 1u == (tg + 1u) * nx) xb_add(&bar[XB_TOPGEN], 1u);
            else XB_SPIN(xb_ld(&bar[XB_TOPGEN]) == tg, bar);
            __builtin_amdgcn_fence(__ATOMIC_ACQUIRE, "agent");
            xb_add(&bar[XB_XGEN(b.x)], 1u);
            asm volatile("s_waitcnt vmcnt(0)" ::: "memory");
        } else {
            XB_SPIN(xb_ld(&bar[XB_XGEN(b.x)]) == gen, bar);
            __builtin_amdgcn_fence(__ATOMIC_ACQUIRE, "agent");
            asm volatile("s_waitcnt vmcnt(0)" ::: "memory");
        }
    }
    __syncthreads();
}
#ifndef N_LAUNCH
#define N_LAUNCH 1
#endif
constexpr int NPHASE = 11;
__global__ void __launch_bounds__(NTHREADS) fwd_kernel(Args a) {
    extern __shared__ __attribute__((aligned(16))) unsigned char lds_raw[];
    LAS unsigned char* lds = (LAS unsigned char*)lds_raw;
    cg::grid_group grid = cg::this_grid();
    const int tid = threadIdx.x, lane = tid & 63, wave = __builtin_amdgcn_readfirstlane(tid >> 6);
    const int G = gridDim.x, bx = blockIdx.x;
    const int vcu = (G % 8 == 0) ? (bx % 8) * (G / 8) + bx / 8 : bx;
    unsigned char* ws = a.ws;
    bf16_t* XB = (bf16_t*)(ws + WS_XB); bf16_t* P = (bf16_t*)(ws + WS_P);
    volatile LAS unsigned* xst = (volatile LAS unsigned*)(lds + 131072 + 1024);
    if (tid < 4) xst[tid] = 0u;
    __syncthreads();
    XcdBarrier xbar; xbar.bar = (unsigned*)ws; xbar.x = 0; xbar.st = xst;
    const int lo = a.ph_lo, hi = a.ph_hi;
#define IN(k) (lo <= (k) && (k) < hi)
#define SEAM(k) do { if (IN(k) && IN((k) + 1)) { if ((k) == 0) grid.sync(); else xcd_barrier(xbar); } } while (0)
    if (IN(0)) {
        if (bx == 0) for (int i = tid; i < 4096; i += NTHREADS) ((unsigned*)ws)[i] = 0u;
        for (int i = bx * NTHREADS + tid; i < (1024 - 64) * 256 / 4; i += G * NTHREADS) ((u32x4*)(ws + 65536))[i] = (u32x4){0u, 0u, 0u, 0u};
        phase_prologue(a, lds, vcu, G, wave, lane);
    }
    SEAM(0);
    xbar = xcd_barrier_post((unsigned*)ws, xst);
    if (IN(1)) {
        pg8::Gemm g{XB, (const bf16_t*)(ws + WS_WIN), T, NP, 1024, 1024, 1024, 128, 128}; pg8::StaticOrder S; S.init(T, NP, G, bx);
        pg8::EpiBf16 E{P, NP, 1, (bf16_t*)(ws + WS_VTB), T, nullptr, 0.f, (float*)(ws + WS_SSQ_CQ), (float*)(ws + WS_SSQ_CKV), nullptr, (bf16_t*)(ws + WS_KB), a.in[10]};
        pg8::gemm_phase<pg8::EpiBf16, pg8::StaticOrder, true, true>(lds, g, S, E);
    }
    SEAM(1);
    if (IN(3)) {
        { pg8::Gemm g{P + C_CQ, (const bf16_t*)(ws + WS_WQB), T, 768, 384, NP, 384, 128, 128}; pg8::StaticOrder S; S.init(T, 768, G, bx);
          pg8::EpiBf16 E{(bf16_t*)(ws + WS_QAR), 768, 0, nullptr, 0, (const float*)(ws + WS_SSQ_CQ), 1.f / 384.f, nullptr, nullptr, nullptr, nullptr, nullptr};
          pg8::gemm_phase<pg8::EpiBf16, pg8::StaticOrder, true, true>(lds, g, S, E); }
        { pg8::Gemm g{P + C_CKV, (const bf16_t*)(ws + WS_WKV), T, 1024, 256, NP, 256, 128, 128}; pg8::StaticOrder S; S.init(T, 1024, G, bx);
          pg8::EpiBf16 E{nullptr, 0, 2, (bf16_t*)(ws + WS_VTA), T, (const float*)(ws + WS_SSQ_CKV), 1.f / 256.f, nullptr, nullptr, P, (bf16_t*)(ws + WS_KA), a.in[8]};
          pg8::gemm_phase<pg8::EpiBf16, pg8::StaticOrder, true, true>(lds, g, S, E); }
    }
    SEAM(3);
    if (IN(5)) { phase_attn(a, lds, vcu, G, tid, wave, lane); }
    SEAM(5);
    if (IN(7)) {
        pg8::Gemm g{(const bf16_t*)(ws + WS_O), (const bf16_t*)(ws + WS_WO), T, 1024, 1024, 1024, 1024, 128, 128}; pg8::StaticOrder S; S.init(T, 1024, G, bx);
        pg8::EpiResX1 E{XB, (const float*)(ws + WS_INVR1), (bf16_t*)(ws + WS_X1B), (float*)(ws + WS_SSQ_X1), DM, (const float*)(ws + WS_SSQ_OA), (const float*)(ws + WS_SSQ_OB)};
        pg8::gemm_phase<pg8::EpiResX1, pg8::StaticOrder, true, true>(lds, g, S, E);
    }
    SEAM(7);
    if (IN(9)) {
        pg8::Gemm g{(const bf16_t*)(ws + WS_X1B), (const bf16_t*)(ws + WS_WGU), T, 2 * DFF, 1024, 1024, 1024, 128, 128}; pg8::StaticOrder S; S.init(T, 2 * DFF, G, bx);
        pg8::EpiSwiGLU E{(bf16_t*)(ws + WS_H), DFF, (const float*)(ws + WS_SSQ_X1), 1.f / 1024.f};
        pg8::gemm_phase<pg8::EpiSwiGLU, pg8::StaticOrder, true, true>(lds, g, S, E);
    }
    SEAM(9);
    if (IN(10)) {
        pg8::Gemm g{(const bf16_t*)(ws + WS_H), (const bf16_t*)(ws + WS_WD), T, 1024, DFF, DFF, DFF, 128, 128}; pg8::StaticOrder S; S.init(T, 1024, G, bx);
        pg8::EpiResB E{(const bf16_t*)(ws + WS_X1B), a.out, DM};
        pg8::gemm_phase<pg8::EpiResB, pg8::StaticOrder, true, true>(lds, g, S, E);
    }
#undef IN
#undef SEAM
}

extern "C" void kernel_launch(void* const* d_in, const int* in_sizes, int n_in, void* d_out, int out_size, void* d_ws, size_t ws_size, hipStream_t stream) {
    static int grid = 0;
    if (grid == 0) {
        if (n_in != 18 || in_sizes[0] != T * DM || out_size != T * DM || ws_size < WS_END) { fprintf(stderr, "kernel_launch: unexpected shapes (n_in %d in0 %d out %d ws %zu)\n", n_in, n_in > 0 ? in_sizes[0] : -1, out_size, ws_size); grid = -1; return; }
        int dev = 0, cus = 0, per_cu = 0;
        hipGetDevice(&dev); hipDeviceGetAttribute(&cus, hipDeviceAttributeMultiprocessorCount, dev);
        if (hipFuncSetAttribute((const void*)fwd_kernel, hipFuncAttributeMaxDynamicSharedMemorySize, LDS_BYTES) != hipSuccess) { fprintf(stderr, "kernel_launch: hipFuncSetAttribute failed\n"); grid = -1; return; }
        if (hipOccupancyMaxActiveBlocksPerMultiprocessor(&per_cu, (const void*)fwd_kernel, NTHREADS, LDS_BYTES) != hipSuccess || per_cu < 1) { fprintf(stderr, "kernel_launch: occupancy query says %d\n", per_cu); per_cu = 1; }
        (void)hipGetLastError();
        grid = cus * 1;
        fprintf(stderr, "kernel_launch: cus %d per_cu %d grid %d\n", cus, per_cu, grid);
    }
    if (grid < 0) return;
    Args a{};
    for (int i = 0; i < 18; ++i) a.in[i] = (const float*)d_in[i];
    a.out = (float*)d_out; a.ws = (unsigned char*)d_ws;
    for (int li = 0; li < N_LAUNCH; ++li) {
        if (N_LAUNCH == 1) { a.ph_lo = 0; a.ph_hi = NPHASE; } else { a.ph_lo = li; a.ph_hi = li + 1; }
        void* args[] = {&a};
        hipError_t e = hipLaunchCooperativeKernel((const void*)fwd_kernel, dim3(grid), dim3(NTHREADS), args, LDS_BYTES, stream);
        if (e != hipSuccess) { fprintf(stderr, "cooperative launch failed: %s (grid %d)\n", hipGetErrorString(e), grid); break; }
    }
}
```

```cpp
#include <hip/hip_runtime.h>
#include <hip/hip_cooperative_groups.h>
#include <cstdio>
#include <cstdint>
namespace cg = cooperative_groups;
constexpr size_t WSC_MiB = 1u << 20;
constexpr size_t WSC_SSQ_X1 = 64 * 1024, WSC_SSQ_CQ = 192 * 1024, WSC_SSQ_CKV = 320 * 1024, WSC_SSQ_OA = 448 * 1024, WSC_SSQ_OB = 576 * 1024;
constexpr size_t WSC_P = 96 * WSC_MiB, WSC_QAR = 192 * WSC_MiB, WSC_KNR = 240 * WSC_MiB, WSC_H = 96 * WSC_MiB, WSC_VTA = 272 * WSC_MiB, WSC_VTB = 304 * WSC_MiB, WSC_X1B = 320 * WSC_MiB;
namespace pg8 {
#define PG8_LAS __attribute__((address_space(3)))
typedef unsigned short bf16_t;
typedef short bf16x8 __attribute__((ext_vector_type(8)));
typedef float f32x4 __attribute__((ext_vector_type(4)));
typedef unsigned u32x4 __attribute__((ext_vector_type(4)));
constexpr int BM = 256, BK = 64, HALF = 128, HTB = HALF * BK * 2  , STAGE_BYTES = 8 * HTB, NXCD = 8, WGM = 8;

__host__ __device__ __forceinline__ int lds_byte(int r, int c) { const int st = (r >> 4) * 2 + (c >> 5), rr = r & 15, cc = c & 31, ob = rr * 64 + cc * 2; return st * 1024 + (ob ^ (((ob >> 9) & 1) << 5)); }
__host__ __device__ __forceinline__ void stage_rc(int b, int& R, int& C) { const int st = b / 1024, sb = b % 1024, swz = sb ^ (((sb >> 9) & 1) << 5); R = (st >> 1) * 16 + swz / 64; C = (st & 1) * 32 + (swz % 64) / 2; }
__host__ __device__ __forceinline__ int perm32(int rho) { const int n = rho >> 4, i = rho & 15; return 8 * (i >> 2) + 4 * n + (i & 3); }

struct Unit { int pm, pn; };
struct Gemm { const bf16_t* A; const bf16_t* Bt; int M, N, K, lda, ldb; size_t kstepA, kstepB; };

struct StaticOrder {
    int nM, nN, nwg, G, c;
    __host__ __device__ void init(int M, int N, int G_, int c_) { nM = M / BM; nN = N / BM; nwg = nM * nN; G = G_; c = c_; }
    __host__ __device__ bool next(int i, Unit& u) const {
        const long L = (long)i * G + c; if (L >= nwg) return false;
        int wgid = (int)L; const int xcd_ = wgid % NXCD; { const int q = nwg / NXCD, r = nwg % NXCD, xcd = wgid % NXCD, off = wgid / NXCD; wgid = (xcd < r ? xcd * (q + 1) : r * (q + 1) + (xcd - r) * q) + off; }
        const int nig = WGM * nN, gid = wgid / nig, fm = gid * WGM, gsz = (nM - fm) < WGM ? (nM - fm) : WGM;
        u.pm = fm + ((wgid % nig) % gsz); u.pn = ((wgid % nig) / gsz + (xcd_ * nN) / NXCD) % nN; return true;
    }
    __device__ __forceinline__ void a_ready(const Unit&) const {}
    __device__ __forceinline__ void done(const Unit&) const {}
};


typedef float f32x2 __attribute__((ext_vector_type(2)));
typedef unsigned u32x2 __attribute__((ext_vector_type(2)));
typedef __bf16 bf16x2v __attribute__((ext_vector_type(2)));
__device__ __forceinline__ unsigned cvt_pk_bf16(float lo, float hi) { f32x2 v = {lo, hi}; bf16x2v b = __builtin_convertvector(v, bf16x2v); return __builtin_bit_cast(unsigned, b); }
__device__ __forceinline__ bf16_t cvt_bf16(float x) { return (bf16_t)(cvt_pk_bf16(x, 0.f) & 0xffffu); }

struct EpiBf16 {
    static constexpr bool PERM = true, AFTER_DRAIN = false, HAS_MID = false;
    bf16_t* O; int ldc; int mode; bf16_t* VT; int ldt; const float* ssq_in; float inv_n; float* ssq_a; float* ssq_b;
    const bf16_t* Pk; bf16_t* Kout; const float* gk;
    __device__ __forceinline__ void vt_store(const f32x4 (&acc)[2][2][4][2], const float (&rs)[2][4], int row0, int vrow0, int fq) const {
        asm volatile("" : "+v"(row0), "+v"(fq));
#pragma unroll
        for (int bj = 0; bj < 2; ++bj)
#pragma unroll
            for (int ai = 0; ai < 2; ++ai)
#pragma unroll
                for (int m = 0; m < 4; ++m) {
                    const f32x4 v0 = acc[ai][bj][m][0] * rs[ai][m], v1 = acc[ai][bj][m][1] * rs[ai][m];
                    bf16_t* p = VT + (size_t)(vrow0 + bj * 32 + 8 * fq) * ldt + (row0 + ai * HALF + m * 16);
#pragma unroll
                    for (int i = 0; i < 4; ++i) { p[(size_t)i * ldt] = cvt_bf16(v0[i]); p[(size_t)(i + 4) * ldt] = cvt_bf16(v1[i]); }
                }
    }
    __device__ __forceinline__ void operator()(const f32x4 (&acc)[2][2][4][2], const Unit& u, int wr, int wc, int fr, int fq) const {
        const int row0 = u.pm * BM + wr * 64 + fr, col0 = u.pn * BM + wc * 32 + 8 * fq;
        float rs[2][4];
#pragma unroll
        for (int ai = 0; ai < 2; ++ai)
#pragma unroll
            for (int m = 0; m < 4; ++m) rs[ai][m] = ssq_in ? (__builtin_amdgcn_rsqf(ssq_in[row0 + ai * HALF + m * 16] * inv_n + 1e-6f)) : 1.0f;
        if (mode == 1 && u.pn == 5) {
            if (wc >= 2) { vt_store(acc, rs, row0, (wc - 2) * 64, fq); return; }
            int fql = fq; asm volatile("" : "+v"(fql));
            float g[2][8], inv[8];
            { const float* gp = gk + 8 * fql;
#pragma unroll
              for (int e = 0; e < 8; ++e) { g[0][e] = gp[e]; g[1][e] = gp[32 + e]; inv[e] = __builtin_amdgcn_exp2f(-(float)(8 * (fql & 1) + e) * (13.287712379549449f / 16.0f)); } }
#pragma unroll
            for (int ai = 0; ai < 2; ++ai)
#pragma unroll
                for (int m = 0; m < 4; ++m) {
                    const int row = row0 + ai * HALF + m * 16, b = row >> 11, s = row & 2047;
                    float v[2][8]; float ss = 0.f;
#pragma unroll
                    for (int bj = 0; bj < 2; ++bj)
#pragma unroll
                        for (int e = 0; e < 8; ++e) { v[bj][e] = acc[ai][bj][m][e >> 2][e & 3]; ss += v[bj][e] * v[bj][e]; }
                    ss += __shfl_xor(ss, 16); ss += __shfl_xor(ss, 32);
                    const float rk = __builtin_amdgcn_rsqf(ss * (1.f / 64.f) + 1e-6f);
                    bf16_t* dst = Kout + ((size_t)(b * 2 + wc) * 2048 + s) * 64 + 8 * fql;
#pragma unroll
                    for (int bj = 0; bj < 2; ++bj) {
                        const float pos = bj ? (float)(s & 63) : (float)(s >> 6);
                        float o[8];
#pragma unroll
                        for (int e = 0; e < 8; ++e) { const float y = v[bj][e] * rk * g[bj][e], py = __shfl_xor(y, 32); const float ang = pos * inv[e], c = __cosf(ang), sn = __sinf(ang);
                            o[e] = (fq & 2) ? (py * sn + y * c) : (y * c - py * sn); }
                        u32x4 w; w.x = cvt_pk_bf16(o[0], o[1]); w.y = cvt_pk_bf16(o[2], o[3]); w.z = cvt_pk_bf16(o[4], o[5]); w.w = cvt_pk_bf16(o[6], o[7]);
                        *(u32x4*)(dst + bj * 32) = w;
                    }
                }
            return;
        }
        if (mode == 2) {
            const int head = 2 * u.pn + (wc >> 1);
            if (wc & 1) { vt_store(acc, rs, row0, head * 64, fq); return; }
            int fql = fq; asm volatile("" : "+v"(fql));
            float g[2][8], gr[8], inv[8];
            { const float* gp = gk + 8 * fql;
#pragma unroll
              for (int e = 0; e < 8; ++e) { g[0][e] = gp[e]; g[1][e] = gp[32 + e]; gr[e] = gp[64 + e]; inv[e] = __builtin_amdgcn_exp2f(-(float)e * (13.287712379549449f / 8.0f)); } }
#pragma unroll
            for (int ai = 0; ai < 2; ++ai)
#pragma unroll
                for (int m = 0; m < 4; ++m) {
                    const int row = row0 + ai * HALF + m * 16, b = row >> 11, s = row & 2047;
                    const u32x4 kw = *(const u32x4*)(Pk + (size_t)row * 1536 + 640 + 8 * fql);
                    float kp[8] = {__uint_as_float(kw.x << 16), __uint_as_float(kw.x & 0xffff0000u), __uint_as_float(kw.y << 16), __uint_as_float(kw.y & 0xffff0000u),
                                   __uint_as_float(kw.z << 16), __uint_as_float(kw.z & 0xffff0000u), __uint_as_float(kw.w << 16), __uint_as_float(kw.w & 0xffff0000u)};
                    float v[2][8]; float ss = 0.f;
#pragma unroll
                    for (int bj = 0; bj < 2; ++bj)
#pragma unroll
                        for (int e = 0; e < 8; ++e) { v[bj][e] = acc[ai][bj][m][e >> 2][e & 3] * rs[ai][m]; ss += v[bj][e] * v[bj][e]; }
#pragma unroll
                    for (int e = 0; e < 8; ++e) ss += kp[e] * kp[e];
                    ss += __shfl_xor(ss, 16); ss += __shfl_xor(ss, 32);
                    const float rk = __builtin_amdgcn_rsqf(ss * (1.f / 96.f) + 1e-6f);
                    bf16_t* dst = Kout + ((size_t)(b * 8 + head) * 2048 + s) * 96 + 8 * fql;
#pragma unroll
                    for (int bj = 0; bj < 2; ++bj) {
                        u32x4 w; w.x = cvt_pk_bf16(v[bj][0] * rk * g[bj][0], v[bj][1] * rk * g[bj][1]); w.y = cvt_pk_bf16(v[bj][2] * rk * g[bj][2], v[bj][3] * rk * g[bj][3]);
                        w.z = cvt_pk_bf16(v[bj][4] * rk * g[bj][4], v[bj][5] * rk * g[bj][5]); w.w = cvt_pk_bf16(v[bj][6] * rk * g[bj][6], v[bj][7] * rk * g[bj][7]);
                        *(u32x4*)(dst + bj * 32) = w;
                    }
                    const float pos = (fq & 2) ? (float)(s & 63) : (float)(s >> 6);
                    float o[8];
#pragma unroll
                    for (int e = 0; e < 8; ++e) { const float y = kp[e] * rk * gr[e], py = __shfl_xor(y, 16); const float ang = pos * inv[e], c = __cosf(ang), sn = __sinf(ang);
                        o[e] = (fq & 1) ? (py * sn + y * c) : (y * c - py * sn); }
                    u32x4 w; w.x = cvt_pk_bf16(o[0], o[1]); w.y = cvt_pk_bf16(o[2], o[3]); w.z = cvt_pk_bf16(o[4], o[5]); w.w = cvt_pk_bf16(o[6], o[7]);
                    *(u32x4*)(dst + 64) = w;
                }
            return;
        }
#pragma unroll
        for (int bj = 0; bj < 2; ++bj) {
            const int c8 = col0 + bj * HALF;
            if (mode == 1) {
                const int cb = u.pn * BM + bj * HALF + wc * 32;
                float* sq = (cb < 384) ? ssq_a : ((cb < 640) ? ssq_b : nullptr);
                if (sq) {
#pragma unroll
                    for (int ai = 0; ai < 2; ++ai)
#pragma unroll
                        for (int m = 0; m < 4; ++m) {
                            const f32x4 v0 = acc[ai][bj][m][0], v1 = acc[ai][bj][m][1];
                            float s = (v0[0] * v0[0] + v0[1] * v0[1]) + (v0[2] * v0[2] + v0[3] * v0[3]) + (v1[0] * v1[0] + v1[1] * v1[1]) + (v1[2] * v1[2] + v1[3] * v1[3]);
                            s += __shfl_xor(s, 16); s += __shfl_xor(s, 32);
                            if (fq == 0) unsafeAtomicAdd(sq + row0 + ai * HALF + m * 16, s);
                        }
                }
            }
#pragma unroll
            for (int ai = 0; ai < 2; ++ai)
#pragma unroll
                for (int m = 0; m < 4; ++m) {
                    const f32x4 v0 = acc[ai][bj][m][0] * rs[ai][m], v1 = acc[ai][bj][m][1] * rs[ai][m];
                    u32x4 w; w.x = cvt_pk_bf16(v0[0], v0[1]); w.y = cvt_pk_bf16(v0[2], v0[3]); w.z = cvt_pk_bf16(v1[0], v1[1]); w.w = cvt_pk_bf16(v1[2], v1[3]);
                    *(u32x4*)(O + (size_t)(row0 + ai * HALF + m * 16) * ldc + c8) = w;
                }
        }
    }
};
struct EpiRes {
    static constexpr bool PERM = false, AFTER_DRAIN = false, HAS_MID = false;
    const float* resid; float* out; int ldc;
    __device__ __forceinline__ void operator()(const f32x4 (&acc)[2][2][4][2], const Unit& u, int wr, int wc, int fr, int fq) const {
        const int row0 = u.pm * BM + wr * 64 + fr, col0 = u.pn * BM + wc * 32 + 4 * fq;
#pragma unroll
        for (int ai = 0; ai < 2; ++ai)
#pragma unroll
            for (int m = 0; m < 4; ++m) {
                const size_t off = (size_t)(row0 + ai * HALF + m * 16) * ldc + col0;
#pragma unroll
                for (int bj = 0; bj < 2; ++bj)
#pragma unroll
                    for (int n = 0; n < 2; ++n) { const f32x4 r = *(const f32x4*)(resid + off + bj * HALF + n * 16); *(f32x4*)(out + off + bj * HALF + n * 16) = r + acc[ai][bj][m][n]; }
            }
    }
};
struct EpiResB {
    static constexpr bool PERM = false, AFTER_DRAIN = false, HAS_MID = false;
    const bf16_t* residb; float* out; int ldc;
    __device__ __forceinline__ void operator()(const f32x4 (&acc)[2][2][4][2], const Unit& u, int wr, int wc, int fr, int fq) const {
        const int row0 = u.pm * BM + wr * 64 + fr, col0 = u.pn * BM + wc * 32 + 4 * fq;
#pragma unroll
        for (int ai = 0; ai < 2; ++ai)
#pragma unroll
            for (int m = 0; m < 4; ++m) {
                const size_t off = (size_t)(row0 + ai * HALF + m * 16) * ldc + col0;
#pragma unroll
                for (int bj = 0; bj < 2; ++bj)
#pragma unroll
                    for (int n = 0; n < 2; ++n) { const u32x2 w = *(const u32x2*)(residb + off + bj * HALF + n * 16);
                        const f32x4 r = {__uint_as_float(w.x << 16), __uint_as_float(w.x & 0xffff0000u), __uint_as_float(w.y << 16), __uint_as_float(w.y & 0xffff0000u)};
                        __builtin_nontemporal_store(r + acc[ai][bj][m][n], (f32x4*)(out + off + bj * HALF + n * 16)); }
            }
    }
};
struct EpiResX1 {
    static constexpr bool PERM = false, AFTER_DRAIN = false, HAS_MID = true; static constexpr int MID_T = 8;
    const bf16_t* residb; const float* invr; bf16_t* xb; float* ssq; int ldc; const float* ssq_a; const float* ssq_b;
    __device__ __forceinline__ void prep(const Unit& u, int ui, PG8_LAS unsigned char* x) const {
        const int tid = threadIdx.x;
        if (tid < 256) { const int row = u.pm * BM + tid; const float ra = __builtin_amdgcn_rsqf(ssq_a[row] * (1.f / 512.f) + 1e-6f), rb = __builtin_amdgcn_rsqf(ssq_b[row] * (1.f / 512.f) + 1e-6f);
            PG8_LAS f32x2* tb = (PG8_LAS f32x2*)(x + 2048 + (ui & 1) * 2048); tb[tid] = (f32x2){ra / rb, rb}; }
    }
    __device__ __forceinline__ void mid(f32x4 (&acc)[2][2][4][2], int ui, int wr, int fr, PG8_LAS unsigned char* x) const {
        const PG8_LAS f32x2* tb = (const PG8_LAS f32x2*)(x + 2048 + (ui & 1) * 2048);
#pragma unroll
        for (int ai = 0; ai < 2; ++ai)
#pragma unroll
            for (int m = 0; m < 4; ++m) { const float q = tb[ai * HALF + wr * 64 + m * 16 + fr].x;
#pragma unroll
                for (int bj = 0; bj < 2; ++bj)
#pragma unroll
                    for (int n = 0; n < 2; ++n) acc[ai][bj][m][n] *= q; }
    }
    __device__ __forceinline__ void fin(const f32x4 (&acc)[2][2][4][2], const Unit& u, int ui, int wr, int wc, int fr, int fq, PG8_LAS unsigned char* x) const {
        const PG8_LAS f32x2* tb = (const PG8_LAS f32x2*)(x + 2048 + (ui & 1) * 2048);
        const int row0 = u.pm * BM + wr * 64 + fr, col0 = u.pn * BM + wc * 32 + 4 * fq;
#pragma unroll
        for (int ai = 0; ai < 2; ++ai)
#pragma unroll
            for (int m = 0; m < 4; ++m) {
                const int row = row0 + ai * HALF + m * 16;
                const float rb = tb[ai * HALF + wr * 64 + m * 16 + fr].y;
                const float ir = invr[row];
                const size_t off = (size_t)row * ldc + col0;
                float s = 0.f;
#pragma unroll
                for (int bj = 0; bj < 2; ++bj)
#pragma unroll
                    for (int n = 0; n < 2; ++n) { const u32x2 xw = *(const u32x2*)(residb + off + bj * HALF + n * 16);
                        const f32x4 xr = {__uint_as_float(xw.x << 16), __uint_as_float(xw.x & 0xffff0000u), __uint_as_float(xw.y << 16), __uint_as_float(xw.y & 0xffff0000u)};
                        const f32x4 v = xr * ir + acc[ai][bj][m][n] * rb;
                        u32x2 w; w.x = cvt_pk_bf16(v[0], v[1]); w.y = cvt_pk_bf16(v[2], v[3]); *(u32x2*)(xb + off + bj * HALF + n * 16) = w;
                        s += (v[0] * v[0] + v[1] * v[1]) + (v[2] * v[2] + v[3] * v[3]); }
                s += __shfl_xor(s, 16); s += __shfl_xor(s, 32);
                if (fq == 0) unsafeAtomicAdd(ssq + row, s);
            }
    }
    __device__ __forceinline__ void operator()(const f32x4 (&acc)[2][2][4][2], const Unit& u, int wr, int wc, int fr, int fq) const {}
};
struct EpiSwiGLU {
    static constexpr bool PERM = true, AFTER_DRAIN = false, HAS_MID = false;
    bf16_t* H; int ldc; const float* ssq; float inv_n;
    __device__ __forceinline__ void operator()(const f32x4 (&acc)[2][2][4][2], const Unit& u, int wr, int wc, int fr, int fq) const {
        const int row0 = u.pm * BM + wr * 64 + fr, col0 = u.pn * HALF + wc * 32 + 8 * fq;
#pragma unroll
        for (int ai = 0; ai < 2; ++ai)
#pragma unroll
            for (int m = 0; m < 4; ++m) {
                float h[8]; const float rs = __builtin_amdgcn_rsqf(ssq[row0 + ai * HALF + m * 16] * inv_n + 1e-6f);
#pragma unroll
                for (int n = 0; n < 2; ++n)
#pragma unroll
                    for (int i = 0; i < 4; ++i) { const float g = acc[ai][0][m][n][i] * rs, up = acc[ai][1][m][n][i] * rs;
                        const float e = __builtin_amdgcn_exp2f(-1.4426950408889634f * g); h[n * 4 + i] = g * __builtin_amdgcn_rcpf(1.0f + e) * up; }
                u32x4 w; w.x = cvt_pk_bf16(h[0], h[1]); w.y = cvt_pk_bf16(h[2], h[3]); w.z = cvt_pk_bf16(h[4], h[5]); w.w = cvt_pk_bf16(h[6], h[7]);
                *(u32x4*)(H + (size_t)(row0 + ai * HALF + m * 16) * ldc + col0) = w;
            }
    }
};

template <class Epi, class Sched, bool ALIGN_EPI = false, bool SP2 = false>
__device__ __forceinline__ void gemm_phase(PG8_LAS unsigned char* lds, const Gemm g, const Sched& S, const Epi& E) {
    const int tid = threadIdx.x, wid = __builtin_amdgcn_readfirstlane(tid >> 6), lane = tid & 63, wr = wid >> 2, wc = wid & 3, fr = lane & 15, fq = lane >> 4;
    const int K = g.K, nt = K / BK;
    unsigned voffA[2], voffB[2];
#pragma unroll
    for (int i = 0; i < 2; ++i) { int R, C; stage_rc(tid * 16 + i * 8192, R, C); const int Rb = Epi::PERM ? ((R & ~31) + perm32(R & 31)) : R;
        voffA[i] = (unsigned)(R * g.lda + C) * 2u; voffB[i] = (unsigned)(Rb * g.ldb + C) * 2u; }
    const size_t kstepA = g.kstepA, kstepB = g.kstepB;
    const size_t hstepA = (size_t)HALF * g.lda * 2, hstepB = (size_t)HALF * g.ldb * 2;
    const size_t tstepA = 2 * hstepA, tstepB = 2 * hstepB;
    const unsigned ldsw = (unsigned)wid * 1024u;
    const int aoff = lds_byte(wr * 64 + fr, fq * 8), boff = lds_byte(wc * 32 + fr, fq * 8);
#define PG8_SA(b, h) (((b) * 2 + (h)) * HTB)
#define PG8_SB(b, h) ((4 + (b) * 2 + (h)) * HTB)
#define PG8_STAGE(bufoff, gbase, voff) do { _Pragma("unroll") for (int _i = 0; _i < 2; ++_i) \
        __builtin_amdgcn_global_load_lds((const unsigned*)((const char*)(gbase) + (voff)[_i]), (PG8_LAS unsigned*)(lds + (bufoff) + ldsw + _i * 8192), 16, 0, 0); } while (0)
#define PG8_LDA(dst, b, h) do { _Pragma("unroll") for (int m = 0; m < 4; ++m) _Pragma("unroll") for (int k = 0; k < 2; ++k) dst[m][k] = *(const PG8_LAS bf16x8*)(lds + PG8_SA(b, h) + aoff + m * 2048 + k * 1024); } while (0)
#define PG8_LDB(dst, b, h) do { _Pragma("unroll") for (int n = 0; n < 2; ++n) _Pragma("unroll") for (int k = 0; k < 2; ++k) dst[n][k] = *(const PG8_LAS bf16x8*)(lds + PG8_SB(b, h) + boff + n * 2048 + k * 1024); } while (0)
#define PG8_MMA(ai, bj, At, Bt) do { __builtin_amdgcn_s_setprio(1); _Pragma("unroll") for (int m = 0; m < 4; ++m) _Pragma("unroll") for (int n = 0; n < 2; ++n) _Pragma("unroll") for (int k = 0; k < 2; ++k) \
        acc[ai][bj][m][n] = __builtin_amdgcn_mfma_f32_16x16x32_bf16(Bt[n][k], At[m][k], acc[ai][bj][m][n], 0, 0, 0); __builtin_amdgcn_s_setprio(0); } while (0)
#define PG8_WAIT_V(n) asm volatile("s_waitcnt vmcnt(" #n ")" ::: "memory")
#define PG8_WAIT_L(n) asm volatile("s_waitcnt lgkmcnt(" #n ")" ::: "memory")
#define PG8_BAR __builtin_amdgcn_s_barrier()
#define PG8_SCHED __builtin_amdgcn_sched_barrier(0)
    Unit cur, nxt; int ui = 0;
    if (!S.next(0, cur)) return;
    f32x4 acc[2][2][4][2];
#pragma unroll
    for (int a = 0; a < 2; ++a)
#pragma unroll
        for (int b = 0; b < 2; ++b)
#pragma unroll
            for (int m = 0; m < 4; ++m)
#pragma unroll
                for (int n = 0; n < 2; ++n) acc[a][b][m][n] = (f32x4){0.f, 0.f, 0.f, 0.f};
    bf16x8 At[4][2], B0[2][2], B1[2][2];
    const char* cA = (const char*)g.A + (size_t)cur.pm * tstepA; const char* cB = (const char*)g.Bt + (size_t)cur.pn * tstepB;
    S.a_ready(cur);
    if constexpr (SP2) {
        PG8_STAGE(PG8_SB(0, 0), cB, voffB); PG8_STAGE(PG8_SB(0, 1), cB + hstepB, voffB); PG8_STAGE(PG8_SA(0, 0), cA, voffA); PG8_STAGE(PG8_SA(0, 1), cA + hstepA, voffA);
        if (wr == 1) PG8_BAR;
        PG8_WAIT_V(2); PG8_BAR;
        PG8_STAGE(PG8_SB(1, 0), cB + kstepB, voffB); PG8_STAGE(PG8_SA(1, 0), cA + kstepA, voffA); PG8_STAGE(PG8_SB(1, 1), cB + hstepB + kstepB, voffB);
        PG8_WAIT_V(6); PG8_BAR;
    } else {
        PG8_STAGE(PG8_SB(0, 0), cB, voffB); PG8_STAGE(PG8_SA(0, 0), cA, voffA); PG8_STAGE(PG8_SB(0, 1), cB + hstepB, voffB); PG8_STAGE(PG8_SA(0, 1), cA + hstepA, voffA);
        if (wr == 1) PG8_BAR;
        PG8_WAIT_V(4); PG8_BAR;
        PG8_STAGE(PG8_SB(1, 0), cB + kstepB, voffB); PG8_STAGE(PG8_SA(1, 0), cA + kstepA, voffA); PG8_STAGE(PG8_SB(1, 1), cB + hstepB + kstepB, voffB);
        PG8_WAIT_V(6); PG8_BAR;
    }
    for (;;) {
        const bool has_next = S.next(ui + 1, nxt);
        if constexpr (Epi::HAS_MID) E.prep(cur, ui, lds + STAGE_BYTES);
        const char* nA = has_next ? (const char*)g.A + (size_t)nxt.pm * tstepA : cA; const char* nB = has_next ? (const char*)g.Bt + (size_t)nxt.pn * tstepB : cB;
        for (int t = 0; t < nt; t += 2) {
            const bool last = (t == nt - 2);
            if constexpr (Epi::HAS_MID) { if (t == Epi::MID_T) E.mid(acc, ui, wr, fr, lds + STAGE_BYTES); }
            const char* a1 = cA + (size_t)(t + 1) * kstepA;
            const char* a2 = last ? nA : cA + (size_t)(t + 2) * kstepA; const char* b2 = last ? nB : cB + (size_t)(t + 2) * kstepB;
            const char* a3 = a2 + kstepA; const char* b3 = b2 + kstepB;
            if (last && has_next) S.a_ready(nxt);
            if constexpr (SP2) {
            PG8_LDB(B0, 0, 0); PG8_LDB(B1, 0, 1); PG8_SCHED; PG8_LDA(At, 0, 0); PG8_STAGE(PG8_SA(1, 1), a1 + hstepA, voffA);
            PG8_WAIT_V(8); PG8_WAIT_L(0); PG8_BAR; PG8_MMA(0, 0, At, B0); PG8_MMA(0, 1, At, B1); PG8_BAR; PG8_SCHED;
            PG8_LDA(At, 0, 1); PG8_STAGE(PG8_SB(0, 0), b2, voffB); PG8_STAGE(PG8_SB(0, 1), b2 + hstepB, voffB); PG8_STAGE(PG8_SA(0, 0), a2, voffA);
            PG8_WAIT_V(8); PG8_WAIT_L(0); PG8_BAR; PG8_MMA(1, 0, At, B0); PG8_MMA(1, 1, At, B1); PG8_BAR; PG8_SCHED;
            PG8_LDB(B0, 1, 0); PG8_LDB(B1, 1, 1); PG8_SCHED; PG8_LDA(At, 1, 0); PG8_STAGE(PG8_SA(0, 1), a2 + hstepA, voffA);
            PG8_WAIT_V(8); PG8_WAIT_L(0); PG8_BAR; PG8_MMA(0, 0, At, B0); PG8_MMA(0, 1, At, B1); PG8_BAR; PG8_SCHED;
            PG8_LDA(At, 1, 1); PG8_STAGE(PG8_SB(1, 0), b3, voffB); PG8_STAGE(PG8_SB(1, 1), b3 + hstepB, voffB); PG8_STAGE(PG8_SA(1, 0), a3, voffA);
            PG8_WAIT_V(8); PG8_WAIT_L(0); PG8_BAR; PG8_MMA(1, 0, At, B0); PG8_MMA(1, 1, At, B1); PG8_BAR; PG8_SCHED;
            } else {
            PG8_LDB(B0, 0, 0); PG8_SCHED; PG8_LDA(At, 0, 0); PG8_STAGE(PG8_SA(1, 1), a1 + hstepA, voffA);
            PG8_WAIT_L(8); PG8_BAR; PG8_WAIT_L(0); PG8_MMA(0, 0, At, B0); PG8_BAR; PG8_SCHED;
            PG8_LDB(B1, 0, 1); PG8_STAGE(PG8_SB(0, 0), b2, voffB);
            PG8_BAR; PG8_WAIT_L(0); PG8_MMA(0, 1, At, B1); PG8_BAR;
            PG8_LDA(At, 0, 1); PG8_STAGE(PG8_SA(0, 0), a2, voffA);
            PG8_BAR; PG8_WAIT_L(0); PG8_MMA(1, 0, At, B0); PG8_BAR; PG8_SCHED;
            PG8_STAGE(PG8_SB(0, 1), b2 + hstepB, voffB);
            PG8_WAIT_V(6); PG8_BAR; PG8_MMA(1, 1, At, B1); PG8_BAR;
            PG8_LDB(B0, 1, 0); PG8_SCHED; PG8_LDA(At, 1, 0); PG8_STAGE(PG8_SA(0, 1), a2 + hstepA, voffA);
            PG8_WAIT_L(8); PG8_BAR; PG8_WAIT_L(0); PG8_MMA(0, 0, At, B0); PG8_BAR; PG8_SCHED;
            PG8_LDB(B1, 1, 1); PG8_STAGE(PG8_SB(1, 0), b3, voffB);
            PG8_BAR; PG8_WAIT_L(0); PG8_MMA(0, 1, At, B1); PG8_BAR;
            PG8_LDA(At, 1, 1); PG8_STAGE(PG8_SA(1, 0), a3, voffA);
            PG8_BAR; PG8_WAIT_L(0); PG8_MMA(1, 0, At, B0); PG8_BAR; PG8_SCHED;
            PG8_STAGE(PG8_SB(1, 1), b3 + hstepB, voffB);
            PG8_WAIT_V(6); PG8_BAR; PG8_MMA(1, 1, At, B1); PG8_BAR;
            }
        }
        if constexpr (ALIGN_EPI) { if (wr == 0) PG8_BAR; }
        if constexpr (!Epi::AFTER_DRAIN) { if constexpr (Epi::HAS_MID) E.fin(acc, cur, ui, wr, wc, fr, fq, lds + STAGE_BYTES); else E(acc, cur, wr, wc, fr, fq); S.done(cur); }
        if (!has_next) break;
#pragma unroll
        for (int a = 0; a < 2; ++a)
#pragma unroll
            for (int b = 0; b < 2; ++b)
#pragma unroll
                for (int m = 0; m < 4; ++m)
#pragma unroll
                    for (int n = 0; n < 2; ++n) acc[a][b][m][n] = (f32x4){0.f, 0.f, 0.f, 0.f};
        cur = nxt; cA = nA; cB = nB; ++ui;
        if constexpr (ALIGN_EPI) { if (wr == 1) PG8_BAR; }
    }
    PG8_WAIT_V(0);
    if constexpr (!ALIGN_EPI) { if (wr == 0) PG8_BAR; }
    PG8_BAR;
    if constexpr (Epi::AFTER_DRAIN) { E.fused(acc, cur, wr, wc, fr, fq, lds, wid, lane); S.done(cur); }
#undef PG8_SA
#undef PG8_SB
#undef PG8_STAGE
#undef PG8_LDA
#undef PG8_LDB
#undef PG8_MMA
#undef PG8_WAIT_V
#undef PG8_WAIT_L
#undef PG8_BAR
#undef PG8_SCHED
}
}

#define LAS __attribute__((address_space(3)))
typedef unsigned short bf16_t;
typedef short bf16x8 __attribute__((ext_vector_type(8)));
typedef float f32x4 __attribute__((ext_vector_type(4)));
typedef float f32x16 __attribute__((ext_vector_type(16)));
typedef unsigned u32x4 __attribute__((ext_vector_type(4)));
typedef unsigned u32x2 __attribute__((ext_vector_type(2)));
using pg8::cvt_pk_bf16;

constexpr int NB = 16, SEQ = 2048, T = NB * SEQ, DM = 1024, GRID_W = 64;
constexpr int NP = 1536;
constexpr int C_CQ = 0, C_CKV = 384, C_KPE = 640, C_GQ = 672, C_GK = 1184, C_GV = 1312, C_END = 1440;
constexpr int DFF = 2816;
constexpr float EPS = 1e-6f;
constexpr float LOG2E = 1.4426950408889634f;
constexpr float LOG2_THETA = 13.287712379549449f;
constexpr int NWAVES = 8, NTHREADS = 512;

constexpr size_t MiB = 1u << 20;
constexpr size_t WS_SSQ_X1 = 64 * 1024, WS_SSQ_CQ = 192 * 1024, WS_SSQ_CKV = 320 * 1024, WS_SSQ_OA = 448 * 1024, WS_SSQ_OB = 576 * 1024;
constexpr size_t WS_X1B = 320 * MiB;
constexpr size_t WS_WIN = 1 * MiB;
constexpr size_t WS_WQB = 4 * MiB;
constexpr size_t WS_WKV = 5 * MiB;
constexpr size_t WS_WO = 6 * MiB;
constexpr size_t WS_WGU = 8 * MiB;
constexpr size_t WS_WD = 19 * MiB;
constexpr size_t WS_XB = 32 * MiB;
constexpr size_t WS_P = 96 * MiB;
constexpr size_t WS_QAR = 192 * MiB;
constexpr size_t WS_KNR = 240 * MiB;
constexpr size_t WS_H = 96 * MiB;
constexpr size_t WS_VTA = 272 * MiB;
constexpr size_t WS_VTB = 304 * MiB;
constexpr size_t WS_QA = 320 * MiB;
constexpr size_t WS_KA = 368 * MiB;
constexpr size_t WS_QB = 416 * MiB;
constexpr size_t WS_KB = 416 * MiB;
constexpr size_t WS_O = 424 * MiB;
constexpr size_t WS_INVR1 = 26 * MiB;
constexpr size_t WS_END = 488 * MiB;

static_assert(WS_P == WSC_P && WS_QAR == WSC_QAR && WS_KNR == WSC_KNR && WS_H == WSC_H && WS_VTA == WSC_VTA && WS_VTB == WSC_VTB && WS_X1B == WSC_X1B && WS_SSQ_X1 == WSC_SSQ_X1 && WS_SSQ_CQ == WSC_SSQ_CQ && WS_SSQ_CKV == WSC_SSQ_CKV && WS_SSQ_OA == WSC_SSQ_OA && WS_SSQ_OB == WSC_SSQ_OB, "d_ws map");
constexpr int LDS_BYTES = 131072 + 8192;

struct Args { const float* in[18]; float* out; unsigned char* ws; int ph_lo, ph_hi; };

__device__ __forceinline__ float wave_sum(float v) {
#pragma unroll
    for (int o = 1; o < 64; o <<= 1) v += __shfl_xor(v, o);
    return v;
}
__device__ __forceinline__ float bf2f(unsigned short h) { return __uint_as_float((unsigned)h << 16); }
__device__ __forceinline__ void unpack8(const u32x4 w, float* f) {
    f[0] = __uint_as_float(w.x << 16); f[1] = __uint_as_float(w.x & 0xffff0000u); f[2] = __uint_as_float(w.y << 16); f[3] = __uint_as_float(w.y & 0xffff0000u);
    f[4] = __uint_as_float(w.z << 16); f[5] = __uint_as_float(w.z & 0xffff0000u); f[6] = __uint_as_float(w.w << 16); f[7] = __uint_as_float(w.w & 0xffff0000u);
}
__device__ __forceinline__ u32x4 pack8(const float* f) { u32x4 w; w.x = cvt_pk_bf16(f[0], f[1]); w.y = cvt_pk_bf16(f[2], f[3]); w.z = cvt_pk_bf16(f[4], f[5]); w.w = cvt_pk_bf16(f[6], f[7]); return w; }

__device__ __forceinline__ void transpose_item(const float* W, int ldw, int k0, int n_src0, bf16_t* WT, int ldt, int dst_row0, const float* gain, LAS float* scr, int lane) {
    float v[32];
    const float* wp = W + (size_t)(k0 + (lane >> 5)) * ldw + n_src0 + (lane & 31);
#pragma unroll
    for (int i = 0; i < 32; ++i) v[i] = __builtin_nontemporal_load(wp + (size_t)(2 * i) * ldw);
    const int c = lane & 7;
    float g[8];
    if (gain) {
        const f32x4 g0 = *(const f32x4*)(gain + k0 + 8 * c), g1 = *(const f32x4*)(gain + k0 + 8 * c + 4);
        g[0] = g0.x; g[1] = g0.y; g[2] = g0.z; g[3] = g0.w; g[4] = g1.x; g[5] = g1.y; g[6] = g1.z; g[7] = g1.w;
    } else {
#pragma unroll
        for (int j = 0; j < 8; ++j) g[j] = 1.0f;
    }
#pragma unroll
    for (int i = 0; i < 32; ++i) scr[(2 * i + (lane >> 5)) * 33 + (lane & 31)] = v[i];
    asm volatile("s_waitcnt lgkmcnt(0)" ::: "memory");
#pragma unroll
    for (int j = 0; j < 4; ++j) { const int n = (lane >> 3) + 8 * j; const LAS float* s = scr + (8 * c) * 33 + n;
        u32x4 o; o.x = cvt_pk_bf16(s[0 * 33] * g[0], s[1 * 33] * g[1]); o.y = cvt_pk_bf16(s[2 * 33] * g[2], s[3 * 33] * g[3]);
        o.z = cvt_pk_bf16(s[4 * 33] * g[4], s[5 * 33] * g[5]); o.w = cvt_pk_bf16(s[6 * 33] * g[6], s[7 * 33] * g[7]);
        *(u32x4*)(WT + (size_t)(dst_row0 + n) * ldt + k0 + 8 * c) = o; }
    asm volatile("s_waitcnt lgkmcnt(0)" ::: "memory");
}

__device__ __forceinline__ void phase_prologue(const Args& a, LAS unsigned char* lds, int vcu, int G, int wave, int lane) {
    unsigned char* ws = a.ws;
    LAS float* scr = (LAS float*)(lds + wave * 16384);
    const int gw = vcu * NWAVES + wave, NGW = G * NWAVES;
    bf16_t* WinT = (bf16_t*)(ws + WS_WIN); bf16_t* WqbT = (bf16_t*)(ws + WS_WQB); bf16_t* WkvT = (bf16_t*)(ws + WS_WKV);
    bf16_t* WoT = (bf16_t*)(ws + WS_WO); bf16_t* WguT = (bf16_t*)(ws + WS_WGU); bf16_t* WdT = (bf16_t*)(ws + WS_WD);
    constexpr int I0 = 16 * 45, I1 = 6 * 24, I2 = 4 * 32, I3 = 16 * 32, I4 = 16 * 88, I5 = 16 * 88, I6 = 44 * 32;
    constexpr int NITEMS = I0 + I1 + I2 + I3 + I4 + I5 + I6;
    for (int pass = 0; pass < 2; ++pass) {
    if ((pass == 0) == ((wave & 1) == 0)) {
    for (int it = gw; it < NITEMS; it += NGW) {
        int r = it;
        if (r < I0) { const int kb = r / 45, nb = r % 45; const int n0 = nb * 32;
            int dr = n0; if (n0 >= 1184) { const int k = (n0 - 1184) & 127, isv = (n0 >= 1312) ? 2 : 0; dr = 1280 + ((k >> 5) & 1) * 128 + (isv + (k >> 6)) * 32; }
            transpose_item(a.in[2], 1440, kb * 64, n0, WinT, 1024, dr, a.in[1], scr, lane); continue; } r -= I0;
        if (r < I1) { const int kb = r / 24, nb = r % 24; transpose_item(a.in[4], 768, kb * 64, nb * 32, WqbT, 384, nb * 32, a.in[3], scr, lane); continue; } r -= I1;
        if (r < I2) { const int kb = r / 32, nb = r % 32; const int head = nb >> 2, part = (nb >> 1) & 1, half = nb & 1;
            transpose_item(a.in[6], 1024, kb * 64, nb * 32, WkvT, 256, 256 * (head >> 1) + 128 * half + 32 * (2 * (head & 1) + part), a.in[5], scr, lane); continue; } r -= I2;
        if (r < I3) { const int kb = r / 32, nb = r % 32; const float* g = (kb < 8) ? a.in[11] : (a.in[12] - 512); transpose_item(a.in[13], 1024, kb * 64, nb * 32, WoT, 1024, nb * 32, g, scr, lane); continue; } r -= I3;
        if (r < I4) { const int kb = r / 88, nb = r % 88; const int n0 = nb * 32; transpose_item(a.in[15], DFF, kb * 64, n0, WguT, 1024, 256 * (n0 >> 7) + (n0 & 127), a.in[14], scr, lane); continue; } r -= I4;
        if (r < I5) { const int kb = r / 88, nb = r % 88; const int n0 = nb * 32; transpose_item(a.in[16], DFF, kb * 64, n0, WguT, 1024, 256 * (n0 >> 7) + 128 + (n0 & 127), a.in[14], scr, lane); continue; } r -= I5;
        { const int kb = r / 32, nb = r % 32; transpose_item(a.in[17], 1024, kb * 64, nb * 32, WdT, DFF, nb * 32, nullptr, scr, lane); }
    }
    for (int i = gw * 64 + lane; i < 96 * 128; i += NGW * 64) ((u32x4*)(WinT + (size_t)1184 * 1024))[i] = (u32x4){0u, 0u, 0u, 0u};
    } else {
    bf16_t* xb = (bf16_t*)(ws + WS_XB);
    for (int m0 = gw; m0 < T; m0 += 4 * NGW) {
        f32x4 v[4][4];
#pragma unroll
        for (int r = 0; r < 4; ++r) { const int m = m0 + r * NGW; if (m < T) { const f32x4* xr = (const f32x4*)(a.in[0] + (size_t)m * DM) + lane;
#pragma unroll
            for (int j = 0; j < 4; ++j) v[r][j] = __builtin_nontemporal_load(xr + 64 * j); } }
#pragma unroll
        for (int r = 0; r < 4; ++r) { const int m = m0 + r * NGW; if (m < T) {
            float s = 0.f;
#pragma unroll
            for (int j = 0; j < 4; ++j) s += (v[r][j].x * v[r][j].x + v[r][j].y * v[r][j].y) + (v[r][j].z * v[r][j].z + v[r][j].w * v[r][j].w);
            const float rt = sqrtf(wave_sum(s) * (1.f / DM) + EPS), rstd = 1.0f / rt;
            if (lane == 0) ((float*)(ws + WS_INVR1))[m] = rt;
            u32x2* o8 = (u32x2*)(xb + (size_t)m * DM) + lane;
#pragma unroll
            for (int j = 0; j < 4; ++j) { u32x2 w; w.x = cvt_pk_bf16(v[r][j].x * rstd, v[r][j].y * rstd); w.y = cvt_pk_bf16(v[r][j].z * rstd, v[r][j].w * rstd); o8[64 * j] = w; } } }
    }
    }
    }
}

__device__ __forceinline__ float max3f(float a, float b, float c) { return __builtin_fmaxf(__builtin_fmaxf(a, b), c); }
template <int DQK>
__device__ __forceinline__ void attn_unit(const bf16_t* Qg, int qpitch, const float* gq, int spos0, const bf16_t* Kg, const bf16_t* Vg, bf16_t* Og, float* ssq, LAS unsigned char* lds, int tid, int wid, int lane) {
    constexpr int KST = DQK * 2 + 16, VST = 144, KBUF = 64 * KST, VBUF = 64 * VST, ND = DQK / 16, CPR = DQK / 8, NCH = 64 * CPR, NT = SEQ / 64;
    constexpr float THR = 8.0f;
    constexpr int NPRE = (DQK == 96) ? ND / 2 : ND; constexpr int NKS = (NPRE < ND) ? 3 : 2;
    constexpr bool NEGM = true;
    const int r32 = lane & 31, hi = lane >> 5;
    bf16x8 qr[ND];
    {
        int r32p = r32, hip = hi; asm volatile("" : "+v"(r32p), "+v"(hip));
        const int spos = spos0 + wid * 32 + r32p;
        asm volatile("" : "+s"(gq));
        const bf16_t* qrow = Qg + (size_t)(wid * 32 + r32p) * qpitch + hip * 8;
        u32x4 raw[ND]; float ss = 0.f;
#pragma unroll
        for (int d0 = 0; d0 < ND; ++d0) raw[d0] = *(const u32x4*)(qrow + d0 * 16);
#pragma unroll
        for (int d0 = 0; d0 < ND; ++d0) { float f[8]; unpack8(raw[d0], f);
#pragma unroll
            for (int j = 0; j < 8; ++j) ss += f[j] * f[j]; }
        ss += __shfl_xor(ss, 32);
        const float qs = (DQK == 96 ? 0.10206207261596577f : 0.125f) * LOG2E;
        const float rs = qs / sqrtf(ss * (1.0f / DQK) + EPS);
        const float prow = (float)(spos >> 6), pcol = (float)(spos & 63);
        constexpr int NPLAIN = (DQK == 96) ? ND - 2 : 0;
#pragma unroll
        for (int d0 = 0; d0 < NPLAIN; ++d0) { float f[8]; unpack8(raw[d0], f);
            const f32x4 g0 = *(const f32x4*)(gq + d0 * 16 + hip * 8), g1 = *(const f32x4*)(gq + d0 * 16 + hip * 8 + 4);
            f[0] *= rs * g0.x; f[1] *= rs * g0.y; f[2] *= rs * g0.z; f[3] *= rs * g0.w; f[4] *= rs * g1.x; f[5] *= rs * g1.y; f[6] *= rs * g1.z; f[7] *= rs * g1.w;
            qr[d0] = __builtin_bit_cast(bf16x8, pack8(f)); }
        if (DQK == 96) {
#pragma unroll
            for (int part = 0; part < 2; ++part) { const int d0 = ND - 2 + part; float f[8]; unpack8(raw[d0], f);
                const f32x4 g0 = *(const f32x4*)(gq + d0 * 16 + hip * 8), g1 = *(const f32x4*)(gq + d0 * 16 + hip * 8 + 4);
                f[0] *= rs * g0.x; f[1] *= rs * g0.y; f[2] *= rs * g0.z; f[3] *= rs * g0.w; f[4] *= rs * g1.x; f[5] *= rs * g1.y; f[6] *= rs * g1.z; f[7] *= rs * g1.w;
#pragma unroll
                for (int j = 0; j < 8; ++j) { const float ang = (part ? pcol : prow) * __builtin_amdgcn_exp2f(-(float)j * (LOG2_THETA / 8.0f)), c = __cosf(ang), sn = __sinf(ang);
                    const float y = f[j], py = __shfl_xor(y, 32); f[j] = hip ? (py * sn + y * c) : (y * c - py * sn); }
                qr[d0] = __builtin_bit_cast(bf16x8, pack8(f)); }
        } else {
#pragma unroll
            for (int part = 0; part < 2; ++part) { float f1[8], f2[8]; unpack8(raw[2 * part], f1); unpack8(raw[2 * part + 1], f2);
                const float* ga = gq + (2 * part) * 16 + hip * 8; const float* gb = gq + (2 * part + 1) * 16 + hip * 8;
#pragma unroll
                for (int j = 0; j < 8; ++j) { const float ang = (part ? pcol : prow) * __builtin_amdgcn_exp2f(-(float)(8 * hip + j) * (LOG2_THETA / 16.0f)), c = __cosf(ang), sn = __sinf(ang);
                    const float x1 = f1[j] * rs * ga[j], x2 = f2[j] * rs * gb[j]; f1[j] = x1 * c - x2 * sn; f2[j] = x1 * sn + x2 * c; }
                qr[2 * part] = __builtin_bit_cast(bf16x8, pack8(f1)); qr[2 * part + 1] = __builtin_bit_cast(bf16x8, pack8(f2)); }
        }
    }
    __builtin_amdgcn_sched_barrier(0);
    const int kl0 = (tid / CPR) * KST + (tid % CPR) * 16;
    const int kl1 = ((tid + 512) / CPR) * KST + ((tid + 512) % CPR) * 16;
    const bool has1 = (NCH > 512) && (tid + 512 < NCH);
    const int vd = tid >> 3, vc = tid & 7;
    const int vl = vd * VST + (16 * (vc >> 1) + 4 * (vc & 1)) * 2;
    const bf16_t* vsrc = Vg + (size_t)vd * T + vc * 8;
    const int kfo = r32 * KST + hi * 16, vfo = r32 * VST + hi * 16;
    u32x4 kreg0, kreg1 = (u32x4){0u, 0u, 0u, 0u}, vreg;
#define AT_GLOADK(t) do { const u32x4* kp_ = (const u32x4*)(Kg + (size_t)(t) * 64 * DQK); kreg0 = kp_[tid]; if (has1) kreg1 = kp_[tid + 512]; } while (0)
#define AT_GLOADV(t) do { vreg = *(const u32x4*)(vsrc + (t) * 64); } while (0)
#define AT_LSTOREK(buf) do { LAS unsigned char* kb_ = lds + (buf) * KBUF; *(LAS u32x4*)(kb_ + kl0) = kreg0; if (has1) *(LAS u32x4*)(kb_ + kl1) = kreg1; } while (0)
#define AT_LSTOREV(buf) do { LAS unsigned char* vb_ = lds + NKS * KBUF + (buf) * VBUF; *(LAS u32x2*)(vb_ + vl) = (u32x2){vreg.x, vreg.y}; *(LAS u32x2*)(vb_ + vl + 16) = (u32x2){vreg.z, vreg.w}; } while (0)
#define AT_BAR() do { asm volatile("s_waitcnt lgkmcnt(0)" ::: "memory"); __builtin_amdgcn_s_barrier(); asm volatile("" ::: "memory"); } while (0)
    float m = 0.f, l = 0.f;
    f32x16 negm;
    f32x16 o0, o1, s0, s1;
    bf16x8 pb[4];
#pragma unroll
    for (int r = 0; r < 16; ++r) { o0[r] = 0.f; o1[r] = 0.f; s0[r] = 0.f; s1[r] = 0.f; negm[r] = 0.f; }
    asm volatile("" : "+v"(negm));
#pragma unroll
    for (int g = 0; g < 4; ++g) pb[g] = (bf16x8){0, 0, 0, 0, 0, 0, 0, 0};
    bf16x8 kf[2 * ND], vf[8];
#define AT_KREADH(slot, lo_, hi_) do { const LAS unsigned char* Kb_ = lds + (slot) * KBUF + kfo; \
        _Pragma("unroll") for (int d0 = (lo_); d0 < (hi_); ++d0) { kf[2 * d0] = *(const LAS bf16x8*)(Kb_ + d0 * 32); kf[2 * d0 + 1] = *(const LAS bf16x8*)(Kb_ + 32 * KST + d0 * 32); } } while (0)
#define AT_KREAD(slot) AT_KREADH(slot, 0, NPRE)
#define AT_VREAD(slot) do { const LAS unsigned char* Vb_ = lds + NKS * KBUF + (slot) * VBUF + vfo; \
        _Pragma("unroll") for (int g = 0; g < 4; ++g) { vf[2 * g] = *(const LAS bf16x8*)(Vb_ + g * 32); vf[2 * g + 1] = *(const LAS bf16x8*)(Vb_ + 32 * VST + g * 32); } } while (0)
#define AT_QKH(lo_, hi_) do { \
        _Pragma("unroll") for (int d0 = (lo_); d0 < (hi_); ++d0) { \
            if (d0 == 0) { s0 = __builtin_amdgcn_mfma_f32_32x32x16_bf16(kf[0], qr[0], negm, 0, 0, 0); s1 = __builtin_amdgcn_mfma_f32_32x32x16_bf16(kf[1], qr[0], negm, 0, 0, 0); } \
            else { s0 = __builtin_amdgcn_mfma_f32_32x32x16_bf16(kf[2 * d0], qr[d0], s0, 0, 0, 0); s1 = __builtin_amdgcn_mfma_f32_32x32x16_bf16(kf[2 * d0 + 1], qr[d0], s1, 0, 0, 0); } } } while (0)
#define AT_SZERO() do { } while (0)
#define AT_PV() do { \
        _Pragma("unroll") for (int g = 0; g < 4; ++g) { \
            o0 = __builtin_amdgcn_mfma_f32_32x32x16_bf16(vf[2 * g], pb[g], o0, 0, 0, 0); \
            o1 = __builtin_amdgcn_mfma_f32_32x32x16_bf16(vf[2 * g + 1], pb[g], o1, 0, 0, 0); } } while (0)
#define AT_SOFTMAX(first_) do { \
        float ta_ = max3f(s0[0], s0[1], s0[2]), tb_ = max3f(s1[0], s1[1], s1[2]); \
        _Pragma("unroll") for (int r = 3; r < 15; r += 2) { ta_ = max3f(ta_, s0[r], s0[r + 1]); tb_ = max3f(tb_, s1[r], s1[r + 1]); } \
        float tm_ = max3f(ta_, tb_, fmaxf(s0[15], s1[15])); \
        { auto rr_ = __builtin_amdgcn_permlane32_swap(__float_as_uint(tm_), __float_as_uint(tm_), false, false); tm_ = fmaxf(__uint_as_float(rr_[0]), __uint_as_float(rr_[1])); } \
        if (!NEGM) tm_ -= m; \
        if ((first_) || __any(tm_ > THR)) { const float dl_ = (first_) ? tm_ : fmaxf(tm_, 0.f), al_ = (first_) ? 1.0f : __builtin_amdgcn_exp2f(-dl_); \
            m += dl_; l *= al_; \
            _Pragma("unroll") for (int r = 0; r < 16; ++r) { o0[r] *= al_; o1[r] *= al_; } \
            if (NEGM) { _Pragma("unroll") for (int r = 0; r < 16; ++r) { s0[r] -= dl_; s1[r] -= dl_; negm[r] = -m; } asm volatile("" : "+v"(negm)); } } \
        if (!NEGM) { _Pragma("unroll") for (int r = 0; r < 16; ++r) { s0[r] -= m; s1[r] -= m; } } \
        float ps_ = 0.f; \
        _Pragma("unroll") for (int r = 0; r < 16; ++r) { s0[r] = __builtin_amdgcn_exp2f(s0[r]); s1[r] = __builtin_amdgcn_exp2f(s1[r]); ps_ += s0[r] + s1[r]; } \
        l += ps_; \
        u32x4 w_; \
        w_.x = cvt_pk_bf16(s0[0], s0[1]); w_.y = cvt_pk_bf16(s0[2], s0[3]); w_.z = cvt_pk_bf16(s0[4], s0[5]); w_.w = cvt_pk_bf16(s0[6], s0[7]); pb[0] = __builtin_bit_cast(bf16x8, w_); \
        w_.x = cvt_pk_bf16(s0[8], s0[9]); w_.y = cvt_pk_bf16(s0[10], s0[11]); w_.z = cvt_pk_bf16(s0[12], s0[13]); w_.w = cvt_pk_bf16(s0[14], s0[15]); pb[1] = __builtin_bit_cast(bf16x8, w_); \
        w_.x = cvt_pk_bf16(s1[0], s1[1]); w_.y = cvt_pk_bf16(s1[2], s1[3]); w_.z = cvt_pk_bf16(s1[4], s1[5]); w_.w = cvt_pk_bf16(s1[6], s1[7]); pb[2] = __builtin_bit_cast(bf16x8, w_); \
        w_.x = cvt_pk_bf16(s1[8], s1[9]); w_.y = cvt_pk_bf16(s1[10], s1[11]); w_.z = cvt_pk_bf16(s1[12], s1[13]); w_.w = cvt_pk_bf16(s1[14], s1[15]); pb[3] = __builtin_bit_cast(bf16x8, w_); } while (0)
    AT_GLOADK(0); AT_GLOADV(0); AT_LSTOREK(0); AT_LSTOREV(0);
    AT_GLOADK(1); AT_LSTOREK(1);
    AT_BAR();
    AT_KREAD(0);
    int ks_cur = 0, ks_next = 1, ks_st = (NKS == 3) ? 2 : 0;
    for (int t = 0; t < NT; ++t) {
        if (t + 2 < NT) AT_GLOADK(t + 2);
        if (t + 1 < NT) AT_GLOADV(t + 1);
        if (NPRE < ND) AT_KREADH(ks_cur, NPRE, ND);
        AT_SZERO();
        AT_QKH(0, ND);
        __builtin_amdgcn_sched_barrier(0);
        AT_VREAD(t & 1);
        __builtin_amdgcn_sched_barrier(0);
        AT_SOFTMAX(t == 0);
        __builtin_amdgcn_sched_barrier(0);
        if (t + 1 < NT) AT_KREAD(ks_next);
        __builtin_amdgcn_sched_barrier(0);
        AT_PV();
        if (t + 2 < NT) AT_LSTOREK(ks_st);
        if (t + 1 < NT) AT_LSTOREV((t + 1) & 1);
        AT_BAR();
        { const int c_ = ks_cur; ks_cur = ks_next; ks_next = ks_st; ks_st = (NKS == 3) ? c_ : ks_cur; }
    }
#undef AT_BAR
#undef AT_GLOADK
#undef AT_GLOADV
#undef AT_LSTOREK
#undef AT_LSTOREV
#undef AT_QKH
#undef AT_SZERO
#undef AT_KREAD
#undef AT_KREADH
#undef AT_VREAD
#undef AT_PV
#undef AT_SOFTMAX
    l += __shfl_xor(l, 32);
    const float il = 1.0f / l;
    {
        float sq = 0.f;
#pragma unroll
        for (int r = 0; r < 16; ++r) { const float a0 = o0[r] * il, a1 = o1[r] * il; sq += a0 * a0 + a1 * a1; }
        sq += __shfl_xor(sq, 32);
        if (hi == 0) unsafeAtomicAdd(ssq + wid * 32 + r32, sq);
    }
    bf16_t* orow = Og + (size_t)(wid * 32 + r32) * DM + 8 * hi;
#pragma unroll
    for (int db = 0; db < 2; ++db)
#pragma unroll
        for (int pr = 0; pr < 2; ++pr) {
            const int ra = 8 * pr, rb = 8 * pr + 4;
            unsigned ax, ay, bx_, by;
            if (db == 0) { ax = cvt_pk_bf16(o0[ra] * il, o0[ra + 1] * il); ay = cvt_pk_bf16(o0[ra + 2] * il, o0[ra + 3] * il); bx_ = cvt_pk_bf16(o0[rb] * il, o0[rb + 1] * il); by = cvt_pk_bf16(o0[rb + 2] * il, o0[rb + 3] * il); }
            else         { ax = cvt_pk_bf16(o1[ra] * il, o1[ra + 1] * il); ay = cvt_pk_bf16(o1[ra + 2] * il, o1[ra + 3] * il); bx_ = cvt_pk_bf16(o1[rb] * il, o1[rb + 1] * il); by = cvt_pk_bf16(o1[rb + 2] * il, o1[rb + 3] * il); }
            const auto sx = __builtin_amdgcn_permlane32_swap(ax, bx_, false, false), sy = __builtin_amdgcn_permlane32_swap(ay, by, false, false);
            u32x4 w; w.x = sx[0]; w.y = sy[0]; w.z = sx[1]; w.w = sy[1];
            *(u32x4*)(orow + 32 * db + 16 * pr) = w;
        }
}

__device__ __forceinline__ void phase_attn(const Args& a, LAS unsigned char* lds, int vcu, int G, int tid, int wid, int lane) {
    unsigned char* ws = a.ws;
    const bf16_t* QAR = (const bf16_t*)(ws + WS_QAR); const bf16_t* Pq = (const bf16_t*)(ws + WS_P); const bf16_t* Ka = (const bf16_t*)(ws + WS_KA); const bf16_t* Vta = (const bf16_t*)(ws + WS_VTA);
    const bf16_t* Kb = (const bf16_t*)(ws + WS_KB); const bf16_t* Vtb = (const bf16_t*)(ws + WS_VTB);
    bf16_t* O = (bf16_t*)(ws + WS_O);
    const int flip = (G == 256) ? (((vcu >> 5) & 1) << 10) : 0;
    for (int u0 = vcu; u0 < 2048; u0 += G) {
        const int u = u0 ^ flip;
        const int grp = u >> 10, id = u & 1023, qb = id & 7, bh = id >> 3, b = bh >> 3, h = bh & 7;
        if (grp == 0) {
            attn_unit<96>(QAR + ((size_t)b * SEQ + qb * 256) * 768 + h * 96, 768, a.in[7], qb * 256, Ka + (size_t)bh * SEQ * 96, Vta + (size_t)(h * 64) * T + (size_t)b * SEQ,
                          O + ((size_t)b * SEQ + qb * 256) * DM + h * 64, (float*)(ws + WS_SSQ_OA) + (size_t)b * SEQ + qb * 256, lds, tid, wid, lane);
        } else {
            const int hk = h >> 2;
            attn_unit<64>(Pq + ((size_t)b * SEQ + qb * 256) * NP + C_GQ + h * 64, NP, a.in[9], qb * 256, Kb + (size_t)(b * 2 + hk) * SEQ * 64, Vtb + (size_t)(hk * 64) * T + (size_t)b * SEQ,
                          O + ((size_t)b * SEQ + qb * 256) * DM + 512 + h * 64, (float*)(ws + WS_SSQ_OB) + (size_t)b * SEQ + qb * 256, lds, tid, wid, lane);
        }
    }
}

#define XB_TMO      128
#define XB_XCNT(j)  (256  + 64 * (j))
#define XB_XSUB(j)  (1280 + 64 * (j))
#define XB_XGEN(j)  (2304 + 64 * (j))
#define XB_TOP      3328
#define XB_TOPGEN   3392
#define XCD_BAR_WORDS 3456
#define XB_SPIN_CAP (1u << 18)

__device__ __forceinline__ unsigned xb_ld(unsigned* p)              { return __hip_atomic_load(p, __ATOMIC_RELAXED, __HIP_MEMORY_SCOPE_AGENT); }
__device__ __forceinline__ unsigned xb_add(unsigned* p, unsigned v) { return __hip_atomic_fetch_add(p, v, __ATOMIC_RELAXED, __HIP_MEMORY_SCOPE_AGENT); }
__device__ __forceinline__ unsigned xb_xcc_id() { return (unsigned)__builtin_amdgcn_s_getreg((3 << 11) | 20) & 0xFu; }
#define XB_SPIN(cond, bar) do { unsigned _sp = 0; while (cond) { __builtin_amdgcn_s_sleep(8); \
    if ((++_sp & 255u) == 0u) { if (xb_ld(&(bar)[XB_TMO])) break; if (_sp > XB_SPIN_CAP) { atomicAdd(&(bar)[XB_TMO], 1u); break; } } } } while (0)

struct XcdBarrier {
    unsigned* bar; unsigned x;
    volatile LAS unsigned* st;
};

__device__ __forceinline__ XcdBarrier xcd_barrier_post(unsigned* bar, volatile LAS unsigned* st) {
    XcdBarrier b; b.bar = bar; b.x = xb_xcc_id(); b.st = st;
    if (threadIdx.x == 0) (void)xb_add(&bar[XB_XCNT(b.x)], 1u);
    return b;
}
__device__ __forceinline__ void xcd_barrier_complete(unsigned* bar, unsigned x, unsigned& nloc, unsigned& nx) {
    const unsigned G = gridDim.x * gridDim.y * gridDim.z;
    unsigned sum, cnt, mine, sp = 0u;
    for (;;) {
        sum = 0u; cnt = 0u; mine = 0u;
#pragma unroll
        for (unsigned j = 0; j < 16; ++j) { const unsigned c = xb_ld(&bar[XB_XCNT(j)]); sum += c; cnt += (c > 0u) ? 1u : 0u; mine = (j == x) ? c : mine; }
        if (sum == G) break;
        __builtin_amdgcn_s_sleep(1);
        if ((++sp & 255u) == 0u) { if (xb_ld(&bar[XB_TMO])) break; if (sp > XB_SPIN_CAP) { atomicAdd(&bar[XB_TMO], 1u); break; } }
    }
    nloc = mine > 0u ? mine : 1u; nx = cnt > 0u ? cnt : 1u;
}

__device__ __forceinline__ void xcd_barrier(const XcdBarrier& b) {
    asm volatile("s_waitcnt vmcnt(0)" ::: "memory");
    __syncthreads();
    if (threadIdx.x == 0) {
        unsigned* bar = b.bar;
        __builtin_amdgcn_s_waitcnt(0);
        unsigned nloc = b.st[0], nx = b.st[1];
        if (nloc == 0u) { xcd_barrier_complete(bar, b.x, nloc, nx); b.st[0] = nloc; b.st[1] = nx; }
        const unsigned old = xb_add(&bar[XB_XSUB(b.x)], 1u);
        const unsigned gen = old / nloc;
        if (old + 1u == (gen + 1u) * nloc) {
            __builtin_amdgcn_fence(__ATOMIC_RELEASE, "agent");
            asm volatile("s_waitcnt vmcnt(0)" ::: "memory");
            const unsigned og = xb_add(&bar[XB_TOP], 1u);
            const unsigned tg = og / nx;
            if (og + 1u == (tg + 1u) * nx) xb_add(&bar[XB_TOPGEN], 1u);
            else XB_SPIN(xb_ld(&bar[XB_TOPGEN]) == tg, bar);
            __builtin_amdgcn_fence(__ATOMIC_ACQUIRE, "agent");
            xb_add(&bar[XB_XGEN(b.x)], 1u);
            asm volatile("s_waitcnt vmcnt(0)" ::: "memory");
        } else {
            XB_SPIN(xb_ld(&bar[XB_XGEN(b.x)]) == gen, bar);
            __builtin_amdgcn_fence(__ATOMIC_ACQUIRE, "agent");
            asm volatile("s_waitcnt vmcnt(0)" ::: "memory");
        }
    }
    __syncthreads();
}
#ifndef N_LAUNCH
#define N_LAUNCH 1
#endif
constexpr int NPHASE = 11;
__global__ void __launch_bounds__(NTHREADS) fwd_kernel(Args a) {
    extern __shared__ __attribute__((aligned(16))) unsigned char lds_raw[];
    LAS unsigned char* lds = (LAS unsigned char*)lds_raw;
    cg::grid_group grid = cg::this_grid();
    const int tid = threadIdx.x, lane = tid & 63, wave = __builtin_amdgcn_readfirstlane(tid >> 6);
    const int G = gridDim.x, bx = blockIdx.x;
    const int vcu = (G % 8 == 0) ? (bx % 8) * (G / 8) + bx / 8 : bx;
    unsigned char* ws = a.ws;
    bf16_t* XB = (bf16_t*)(ws + WS_XB); bf16_t* P = (bf16_t*)(ws + WS_P);
    volatile LAS unsigned* xst = (volatile LAS unsigned*)(lds + 131072 + 1024);
    if (tid < 4) xst[tid] = 0u;
    __syncthreads();
    XcdBarrier xbar; xbar.bar = (unsigned*)ws; xbar.x = 0; xbar.st = xst;
    const int lo = a.ph_lo, hi = a.ph_hi;
#define IN(k) (lo <= (k) && (k) < hi)
#define SEAM(k) do { if (IN(k) && IN((k) + 1)) { if ((k) == 0) grid.sync(); else xcd_barrier(xbar); } } while (0)
    if (IN(0)) {
        if (bx == 0) for (int i = tid; i < 4096; i += NTHREADS) ((unsigned*)ws)[i] = 0u;
        for (int i = bx * NTHREADS + tid; i < (1024 - 64) * 256 / 4; i += G * NTHREADS) ((u32x4*)(ws + 65536))[i] = (u32x4){0u, 0u, 0u, 0u};
        phase_prologue(a, lds, vcu, G, wave, lane);
    }
    SEAM(0);
    xbar = xcd_barrier_post((unsigned*)ws, xst);
    if (IN(1)) {
        pg8::Gemm g{XB, (const bf16_t*)(ws + WS_WIN), T, NP, 1024, 1024, 1024, 128, 128}; pg8::StaticOrder S; S.init(T, NP, G, bx);
        pg8::EpiBf16 E{P, NP, 1, (bf16_t*)(ws + WS_VTB), T, nullptr, 0.f, (float*)(ws + WS_SSQ_CQ), (float*)(ws + WS_SSQ_CKV), nullptr, (bf16_t*)(ws + WS_KB), a.in[10]};
        pg8::gemm_phase<pg8::EpiBf16, pg8::StaticOrder, true, true>(lds, g, S, E);
    }
    SEAM(1);
    if (IN(3)) {
        { pg8::Gemm g{P + C_CQ, (const bf16_t*)(ws + WS_WQB), T, 768, 384, NP, 384, 128, 128}; pg8::StaticOrder S; S.init(T, 768, G, bx);
          pg8::EpiBf16 E{(bf16_t*)(ws + WS_QAR), 768, 0, nullptr, 0, (const float*)(ws + WS_SSQ_CQ), 1.f / 384.f, nullptr, nullptr, nullptr, nullptr, nullptr};
          pg8::gemm_phase<pg8::EpiBf16, pg8::StaticOrder, true, true>(lds, g, S, E); }
        { pg8::Gemm g{P + C_CKV, (const bf16_t*)(ws + WS_WKV), T, 1024, 256, NP, 256, 128, 128}; pg8::StaticOrder S; S.init(T, 1024, G, bx);
          pg8::EpiBf16 E{nullptr, 0, 2, (bf16_t*)(ws + WS_VTA), T, (const float*)(ws + WS_SSQ_CKV), 1.f / 256.f, nullptr, nullptr, P, (bf16_t*)(ws + WS_KA), a.in[8]};
          pg8::gemm_phase<pg8::EpiBf16, pg8::StaticOrder, true, true>(lds, g, S, E); }
    }
    SEAM(3);
    if (IN(5)) { phase_attn(a, lds, vcu, G, tid, wave, lane); }
    SEAM(5);
    if (IN(7)) {
        pg8::Gemm g{(const bf16_t*)(ws + WS_O), (const bf16_t*)(ws + WS_WO), T, 1024, 1024, 1024, 1024, 128, 128}; pg8::StaticOrder S; S.init(T, 1024, G, bx);
        pg8::EpiResX1 E{XB, (const float*)(ws + WS_INVR1), (bf16_t*)(ws + WS_X1B), (float*)(ws + WS_SSQ_X1), DM, (const float*)(ws + WS_SSQ_OA), (const float*)(ws + WS_SSQ_OB)};
        pg8::gemm_phase<pg8::EpiResX1, pg8::StaticOrder, true, true>(lds, g, S, E);
    }
    SEAM(7);
    if (IN(9)) {
        pg8::Gemm g{(const bf16_t*)(ws + WS_X1B), (const bf16_t*)(ws + WS_WGU), T, 2 * DFF, 1024, 1024, 1024, 128, 128}; pg8::StaticOrder S; S.init(T, 2 * DFF, G, bx);
        pg8::EpiSwiGLU E{(bf16_t*)(ws + WS_H), DFF, (const float*)(ws + WS_SSQ_X1), 1.f / 1024.f};
        pg8::gemm_phase<pg8::EpiSwiGLU, pg8::StaticOrder, true, true>(lds, g, S, E);
    }
    SEAM(9);
    if (IN(10)) {
        pg8::Gemm g{(const bf16_t*)(ws + WS_H), (const bf16_t*)(ws + WS_WD), T, 1024, DFF, DFF, DFF, 128, 128}; pg8::StaticOrder S; S.init(T, 1024, G, bx);
        pg8::EpiResB E{(const bf16_t*)(ws + WS_X1B), a.out, DM};
        pg8::gemm_phase<pg8::EpiResB, pg8::StaticOrder, true, true>(lds, g, S, E);
    }
#undef IN
#undef SEAM
}

extern "C" void kernel_launch(void* const* d_in, const int* in_sizes, int n_in, void* d_out, int out_size, void* d_ws, size_t ws_size, hipStream_t stream) {
    static int grid = 0;
    if (grid == 0) {
        if (n_in != 18 || in_sizes[0] != T * DM || out_size != T * DM || ws_size < WS_END) { fprintf(stderr, "kernel_launch: unexpected shapes (n_in %d in0 %d out %d ws %zu)\n", n_in, n_in > 0 ? in_sizes[0] : -1, out_size, ws_size); grid = -1; return; }
        int dev = 0, cus = 0, per_cu = 0;
        hipGetDevice(&dev); hipDeviceGetAttribute(&cus, hipDeviceAttributeMultiprocessorCount, dev);
        if (hipFuncSetAttribute((const void*)fwd_kernel, hipFuncAttributeMaxDynamicSharedMemorySize, LDS_BYTES) != hipSuccess) { fprintf(stderr, "kernel_launch: hipFuncSetAttribute failed\n"); grid = -1; return; }
        if (hipOccupancyMaxActiveBlocksPerMultiprocessor(&per_cu, (const void*)fwd_kernel, NTHREADS, LDS_BYTES) != hipSuccess || per_cu < 1) { fprintf(stderr, "kernel_launch: occupancy query says %d\n", per_cu); per_cu = 1; }
        (void)hipGetLastError();
        grid = cus * 1;
        fprintf(stderr, "kernel_launch: cus %d per_cu %d grid %d\n", cus, per_cu, grid);
    }
    if (grid < 0) return;
    Args a{};
    for (int i = 0; i < 18; ++i) a.in[i] = (const float*)d_in[i];
    a.out = (float*)d_out; a.ws = (unsigned char*)d_ws;
    for (int li = 0; li < N_LAUNCH; ++li) {
        if (N_LAUNCH == 1) { a.ph_lo = 0; a.ph_hi = NPHASE; } else { a.ph_lo = li; a.ph_hi = li + 1; }
        void* args[] = {&a};
        hipError_t e = hipLaunchCooperativeKernel((const void*)fwd_kernel, dim3(grid), dim3(NTHREADS), args, LDS_BYTES, stream);
        if (e != hipSuccess) { fprintf(stderr, "cooperative launch failed: %s (grid %d)\n", hipGetErrorString(e), grid); break; }
    }
}
```
